# Optimizing an MI355X kernel written in HIP

```python
import math
import jax, jax.numpy as jnp
from jax import lax
import numpy as np

D_MODEL = 1024
BATCH = 8
SEQ = 4096
DEPTH = 1

MEM_LEN = 256
EPS = 1e-6

LRU_WIDTH = 512
LRU_BLOCKS = 8
LRU_BLOCK = LRU_WIDTH // LRU_BLOCKS
CONV_WIDTH = 4
LRU_C = 8.0

MLA_HEADS = 8
Q_LORA = 256
KV_LORA = 128
QK_NOPE = 64
QK_ROPE = 32
V_HEAD = 64
MLA_WIDTH = MLA_HEADS * V_HEAD
ROPE_THETA = 10000.0
Q_BLOCK = 128

MEM_HEADS = 4
MEM_HEAD_DIM = 128
MEM_WIDTH = MEM_HEADS * MEM_HEAD_DIM

N_BRANCH = 3
BRANCH_WIDTH = 512

N_GROUPS = 4
EXPERTS_PER_GROUP = 8
N_EXPERTS = N_GROUPS * EXPERTS_PER_GROUP
TOP_K = 2
D_EXPERT = 256

IN_SIZES = (LRU_WIDTH, LRU_WIDTH, Q_LORA, KV_LORA + QK_ROPE, MEM_WIDTH, N_BRANCH * D_MODEL)
D_IN = LRU_WIDTH * 2 + Q_LORA + KV_LORA + QK_ROPE + MEM_WIDTH + N_BRANCH * D_MODEL

kernel_name = "hybrid_rglru_mla_memxattn_hiermoe"


def _split_points(sizes):
    pts, acc = [], 0
    for s in sizes[:-1]:
        acc += s
        pts.append(acc)
    return pts


def rmsnorm(x, g):
    xf = x.astype(jnp.float32)
    y = xf * lax.rsqrt(jnp.mean(xf * xf, axis=-1, keepdims=True) + EPS)
    return (y * g.astype(jnp.float32)).astype(x.dtype)


def rope_angles(positions):
    inv_freq = ROPE_THETA ** (-jnp.arange(0, QK_ROPE, 2, dtype=jnp.float32) / QK_ROPE)
    ang = positions.astype(jnp.float32)[..., None] * inv_freq
    return jnp.cos(ang), jnp.sin(ang)


def apply_rope(t, cos, sin):
    tf = t.astype(jnp.float32)
    half = tf.shape[-1] // 2
    t1, t2 = tf[..., :half], tf[..., half:]
    return jnp.concatenate([t1 * cos - t2 * sin, t2 * cos + t1 * sin], axis=-1).astype(t.dtype)


def causal_depthwise_conv(x, w, b):
    R = x.shape[-1]
    y = lax.conv_general_dilated(
        x, w.astype(x.dtype)[:, None, :], window_strides=(1,), padding=[(CONV_WIDTH - 1, 0)],
        dimension_numbers=('NWC', 'WIO', 'NWC'), feature_group_count=R)
    return y + b.astype(x.dtype)


def rg_lru(xc, w_a, b_a, w_x, b_x, lam):
    B, S, R = xc.shape
    xb = xc.reshape(B, S, LRU_BLOCKS, LRU_BLOCK)
    gate_a = jnp.einsum('bsnc,ncd->bsnd', xb, w_a).reshape(B, S, R) + b_a
    gate_x = jnp.einsum('bsnc,ncd->bsnd', xb, w_x).reshape(B, S, R) + b_x
    r = jax.nn.sigmoid(gate_a.astype(jnp.float32))
    i = jax.nn.sigmoid(gate_x.astype(jnp.float32))
    log_a = -LRU_C * r * jax.nn.softplus(-lam.astype(jnp.float32))
    a = jnp.exp(log_a)
    u = jnp.sqrt(-jnp.expm1(2.0 * log_a)) * (i * xc.astype(jnp.float32))

    def combine(left, right):
        a_l, b_l = left
        a_r, b_r = right
        return a_l * a_r, a_r * b_l + b_r

    _, h = lax.associative_scan(combine, (a, u), axis=1)
    return h.astype(xc.dtype)


def mla_attention(q_nope, q_rope, k_nope, k_rope, v):
    B, S, H, _ = q_nope.shape
    nb = S // Q_BLOCK
    scale = 1.0 / math.sqrt(QK_NOPE + QK_ROPE)

    def to_blocks(t):
        return jnp.moveaxis(t.reshape((B, nb, Q_BLOCK) + t.shape[2:]), 1, 0)

    k_pos = jnp.arange(S)

    def one_block(args):
        qn, qr, start = args
        s = (jnp.einsum('bqhd,bkhd->bhqk', qn, k_nope, preferred_element_type=jnp.float32)
             + jnp.einsum('bqhr,bkr->bhqk', qr, k_rope, preferred_element_type=jnp.float32)) * scale
        q_pos = start + jnp.arange(Q_BLOCK)
        s = jnp.where(k_pos[None, :] <= q_pos[:, None], s, -jnp.inf)
        p = jax.nn.softmax(s, axis=-1).astype(v.dtype)
        return jnp.einsum('bhqk,bkhd->bqhd', p, v)

    starts = jnp.arange(nb) * Q_BLOCK
    out = lax.map(one_block, (to_blocks(q_nope), to_blocks(q_rope), starts))
    return jnp.moveaxis(out, 0, 1).reshape(B, S, H * V_HEAD)


def memory_attention(q, mem_n, w_kv):
    B, S, _ = q.shape
    M = mem_n.shape[1]
    qh = q.reshape(B, S, MEM_HEADS, MEM_HEAD_DIM)
    k, v = jnp.split(mem_n @ w_kv, 2, axis=-1)
    k = k.reshape(B, M, MEM_HEADS, MEM_HEAD_DIM)
    v = v.reshape(B, M, MEM_HEADS, MEM_HEAD_DIM)
    s = jnp.einsum('bshd,bmhd->bhsm', qh, k, preferred_element_type=jnp.float32) / math.sqrt(MEM_HEAD_DIM)
    p = jax.nn.softmax(s, axis=-1).astype(v.dtype)
    return jnp.einsum('bhsm,bmhd->bshd', p, v).reshape(B, S, MEM_WIDTH)


def hier_moe(n2, w_group, b_group, w_router, b_router, w_e_gate, w_e_up, w_e_down):
    B, S, D = n2.shape
    t = n2.reshape(B * S, D)
    g_logits = (t @ w_group).astype(jnp.float32) + b_group.astype(jnp.float32)
    g_prob = jax.nn.softmax(g_logits, axis=-1)
    g_w, g_idx = lax.top_k(g_prob, 1)
    e_logits = ((t @ w_router).astype(jnp.float32) + b_router.astype(jnp.float32)).reshape(-1, N_GROUPS, EXPERTS_PER_GROUP)
    e_in_group = jnp.take_along_axis(e_logits, g_idx[:, :, None], axis=1)[:, 0]
    top_vals, top_idx = lax.top_k(e_in_group, TOP_K)
    top_w = jax.nn.softmax(top_vals, axis=-1) * g_w
    expert_id = g_idx * EXPERTS_PER_GROUP + top_idx
    combine = jnp.einsum('tk,tke->te', top_w, jax.nn.one_hot(expert_id, N_EXPERTS, dtype=jnp.float32)).astype(t.dtype)
    y = jnp.zeros_like(t)
    for e in range(N_EXPERTS):
        hidden = jax.nn.silu(t @ w_e_gate[e]) * (t @ w_e_up[e])
        y = y + combine[:, e:e + 1] * (hidden @ w_e_down[e])
    return y.reshape(B, S, D)


def setup_inputs(seed: int = 0) -> dict:
    key = jax.random.key(seed)
    ks = iter(jax.random.split(key, 40))
    f32 = jnp.float32

    def nrm(shape, fan_in):
        return jax.random.normal(next(ks), shape, f32) * (fan_in ** -0.5)

    def gain(shape):
        return 1.0 + 0.02 * jax.random.normal(next(ks), shape, f32)

    def bias(shape, scale=0.02):
        return scale * jax.random.normal(next(ks), shape, f32)

    x = jax.random.normal(next(ks), (BATCH, SEQ, D_MODEL), f32)
    mem = jax.random.normal(next(ks), (BATCH, MEM_LEN, D_MODEL), f32)
    offsets = jax.random.randint(next(ks), (BATCH, 1), 0, 1024, dtype=jnp.int32)
    positions = offsets + jnp.arange(SEQ, dtype=jnp.int32)[None, :]

    u = jax.random.uniform(next(ks), (DEPTH, LRU_WIDTH), f32, 0.9, 0.999)
    a0 = u ** (1.0 / LRU_C)
    lru_lambda = jnp.log(a0) - jnp.log1p(-a0)

    return {
        "x": x,
        "mem": mem,
        "positions": positions,
        "g_mix": gain((DEPTH, D_MODEL)),
        "w_in": nrm((DEPTH, D_MODEL, D_IN), D_MODEL),
        "conv_w": nrm((DEPTH, CONV_WIDTH, LRU_WIDTH), CONV_WIDTH),
        "conv_b": bias((DEPTH, LRU_WIDTH)),
        "lru_wa": nrm((DEPTH, LRU_BLOCKS, LRU_BLOCK, LRU_BLOCK), LRU_BLOCK),
        "lru_ba": bias((DEPTH, LRU_WIDTH)),
        "lru_wx": nrm((DEPTH, LRU_BLOCKS, LRU_BLOCK, LRU_BLOCK), LRU_BLOCK),
        "lru_bx": bias((DEPTH, LRU_WIDTH)),
        "lru_lambda": lru_lambda,
        "g_q": gain((DEPTH, Q_LORA)),
        "w_uq": nrm((DEPTH, Q_LORA, MLA_HEADS * (QK_NOPE + QK_ROPE)), Q_LORA),
        "g_kv": gain((DEPTH, KV_LORA)),
        "w_ukv": nrm((DEPTH, KV_LORA, MLA_HEADS * (QK_NOPE + V_HEAD)), KV_LORA),
        "g_mem": gain((DEPTH, D_MODEL)),
        "w_mem_kv": nrm((DEPTH, D_MODEL, 2 * MEM_WIDTH), D_MODEL),
        "w_branch": nrm((DEPTH, N_BRANCH, BRANCH_WIDTH, D_MODEL), BRANCH_WIDTH),
        "w_o": nrm((DEPTH, D_MODEL, D_MODEL), D_MODEL),
        "g_ffn": gain((DEPTH, D_MODEL)),
        "w_group": nrm((DEPTH, D_MODEL, N_GROUPS), D_MODEL),
        "b_group": bias((DEPTH, N_GROUPS), 0.01),
        "w_router": nrm((DEPTH, D_MODEL, N_EXPERTS), D_MODEL),
        "b_router": bias((DEPTH, N_EXPERTS), 0.01),
        "w_e_gate": nrm((DEPTH, N_EXPERTS, D_MODEL, D_EXPERT), D_MODEL),
        "w_e_up": nrm((DEPTH, N_EXPERTS, D_MODEL, D_EXPERT), D_MODEL),
        "w_e_down": nrm((DEPTH, N_EXPERTS, D_EXPERT, D_MODEL), D_EXPERT),
        "g_final": gain((D_MODEL,)),
    }


def reference(x, mem, positions, g_mix, w_in, conv_w, conv_b, lru_wa, lru_ba, lru_wx, lru_bx, lru_lambda,
              g_q, w_uq, g_kv, w_ukv, g_mem, w_mem_kv, w_branch, w_o, g_ffn, w_group, b_group,
              w_router, b_router, w_e_gate, w_e_up, w_e_down, g_final):
    B, S, D = x.shape
    cos, sin = rope_angles(positions)
    split_pts = _split_points(IN_SIZES)
    h = x
    for l in range(DEPTH):
        n = rmsnorm(h, g_mix[l])
        proj = n @ w_in[l]
        x_lru, gate_lru, c_q, kv_a, q_mem, gate_logits = jnp.split(proj, split_pts, axis=-1)

        xa = causal_depthwise_conv(x_lru, conv_w[l], conv_b[l])
        y_a = rg_lru(xa, lru_wa[l], lru_ba[l], lru_wx[l], lru_bx[l], lru_lambda[l]) * jax.nn.gelu(gate_lru)

        cq = rmsnorm(c_q, g_q[l])
        q = (cq @ w_uq[l]).reshape(B, S, MLA_HEADS, QK_NOPE + QK_ROPE)
        q_nope = q[..., :QK_NOPE]
        q_rope = apply_rope(q[..., QK_NOPE:], cos[:, :, None, :], sin[:, :, None, :])
        ckv = rmsnorm(kv_a[..., :KV_LORA], g_kv[l])
        k_rope = apply_rope(kv_a[..., KV_LORA:], cos, sin)
        kv = (ckv @ w_ukv[l]).reshape(B, S, MLA_HEADS, QK_NOPE + V_HEAD)
        y_b = mla_attention(q_nope, q_rope, kv[..., :QK_NOPE], k_rope, kv[..., QK_NOPE:])

        mem_n = rmsnorm(mem, g_mem[l])
        y_c = memory_attention(q_mem, mem_n, w_mem_kv[l])

        gl = gate_logits.reshape(B, S, N_BRANCH, D)
        merged = (jax.nn.sigmoid(gl[:, :, 0].astype(jnp.float32)).astype(h.dtype) * (y_a @ w_branch[l, 0])
                  + jax.nn.sigmoid(gl[:, :, 1].astype(jnp.float32)).astype(h.dtype) * (y_b @ w_branch[l, 1])
                  + jax.nn.sigmoid(gl[:, :, 2].astype(jnp.float32)).astype(h.dtype) * (y_c @ w_branch[l, 2]))
        h = h + merged @ w_o[l]

        n2 = rmsnorm(h, g_ffn[l])
        h = h + hier_moe(n2, w_group[l], b_group[l], w_router[l], b_router[l],
                         w_e_gate[l], w_e_up[l], w_e_down[l])
    return rmsnorm(h, g_final)
```

```cpp
#include <hip/hip_runtime.h>
#include <cstdio>
#include <cstdint>

#define GAS __attribute__((address_space(1)))
#define LAS __attribute__((address_space(3)))
typedef unsigned short bf16;
typedef unsigned v4u __attribute__((ext_vector_type(4)));
typedef unsigned v2u __attribute__((ext_vector_type(2)));
typedef float f32x4 __attribute__((ext_vector_type(4)));
typedef float f32x2 __attribute__((ext_vector_type(2)));
typedef float f32x16 __attribute__((ext_vector_type(16)));
typedef short bf16x8 __attribute__((ext_vector_type(8)));
typedef int i32x4 __attribute__((ext_vector_type(4)));
typedef int i32x8 __attribute__((ext_vector_type(8)));
#define RLX_AGENT __ATOMIC_RELAXED, __HIP_MEMORY_SCOPE_AGENT
#define LDS_WAIT() asm volatile("s_waitcnt lgkmcnt(0)" ::: "memory")
#define VM_WAIT() asm volatile("s_waitcnt vmcnt(0)" ::: "memory")

#ifndef DBG_BR
#define DBG_BR 7
#endif
#ifndef DBG_OUT
#define DBG_OUT 0
#endif
#ifndef PROBE_REP
#define PROBE_REP 0
#endif
#define REPN(k) ((((PROBE_REP) >> (k)) & 1) ? 2 : 1)
#ifndef PROBE_SKIP
#define PROBE_SKIP 0
#endif
#ifndef MK_SPLIT
#define MK_SPLIT 0
#endif

constexpr int NB = 8, SEQ = 4096, T = NB * SEQ, DM = 1024, MEMLEN = 256, MROWS = NB * MEMLEN;
constexpr int NPROJ = 5120;
constexpr int NEXP = 32, DEXP = 256;
constexpr float EPS = 1e-6f;
constexpr float LOG2E = 1.4426950408889634f;
constexpr float C2_MLA = 0.10206207261596575f * LOG2E;
constexpr float C2_MEM = 0.08838834764831845f * LOG2E;
constexpr int NWAVES = 8;
constexpr int MAXTILES = 288;

constexpr size_t MiB = 1u << 20;
constexpr size_t WS_CTL = 0, CTL_ZERO_BYTES = 1 * MiB;
constexpr size_t WS_WIN = 1 * MiB;
constexpr size_t WS_WG8 = 5 * MiB;
constexpr size_t WS_WUQ = 11 * MiB;
constexpr size_t WS_WK = 11 * MiB + 512 * 1024;
constexpr size_t WS_WV = 11 * MiB + 768 * 1024;
constexpr size_t WS_WMK = 12 * MiB;
constexpr size_t WS_WMV = 13 * MiB;
constexpr size_t WS_WBR = 14 * MiB;
constexpr size_t WS_WO = 17 * MiB;
constexpr size_t WS_WR = 19 * MiB;
constexpr size_t WS_WLRU = 19 * MiB + 512 * 1024;
constexpr size_t WS_COS = 20 * MiB, WS_SIN = 22 * MiB;
constexpr size_t WS_W1 = 24 * MiB;
constexpr size_t WS_W2 = 56 * MiB;
constexpr size_t WS_LSUM = 72 * MiB;
constexpr size_t WS_LTOK = 73 * MiB;
constexpr size_t WS_LW = 77 * MiB;
constexpr size_t WS_PICK = 81 * MiB;
constexpr size_t WS_XN = 84 * MiB;
constexpr size_t WS_MG = WS_XN;
constexpr size_t WS_MEMN = 148 * MiB;
constexpr size_t WS_MK = 152 * MiB;
constexpr size_t WS_MVT = 154 * MiB;
constexpr size_t WS_XL = 156 * MiB;
constexpr size_t WS_GL = 188 * MiB;
constexpr size_t WS_HB = 156 * MiB;
constexpr size_t WS_CQ = 220 * MiB;
constexpr size_t WS_CKV = 236 * MiB;
constexpr size_t WS_HB8 = 220 * MiB;
constexpr size_t WS_YB = 220 * MiB;
constexpr size_t WS_QM = 252 * MiB;
constexpr size_t WS_SG = 284 * MiB;
constexpr size_t WS_HD = 284 * MiB;
constexpr size_t WS_YE = 320 * MiB;
constexpr size_t WS_YC8 = 384 * MiB;
constexpr size_t WS_SSQQ = 476 * MiB;
constexpr size_t WS_SSQKV = 476 * MiB + 512 * 1024;
constexpr size_t WS_SSQH = 477 * MiB;
constexpr size_t WS_RSH = 479 * MiB;
constexpr size_t WS_END = 480 * MiB;
constexpr size_t DO_Q = 0, DO_K = 48 * MiB, DO_KR = 80 * MiB, DO_VT = 96 * MiB;
constexpr size_t DO_XN8 = 0;
constexpr float WG8_SCALE = 64.0f, W18_SCALE = 64.0f;
constexpr float WU8_SCALE = 64.0f, CL8_SCALE = 8.0f;
constexpr float W28_SCALE = 64.0f, HD8_SCALE = 8.0f;
constexpr float WB8_SCALE = 64.0f, Y8_SCALE = 32.0f;
#ifndef GATE_UNSCALE
#define GATE_UNSCALE (1.0f / WG8_SCALE)
#endif
constexpr int CW_TMO = 0;
constexpr int CW_BAR = 4096;
constexpr int CW_CNT = 8192;
constexpr int CW_SSQQ = 65536, CW_SSQKV = 65536 + 32768, CW_SSQH = 65536 + 65536;

constexpr int RING_BYTES = 131072;
constexpr int MOE_OFF = RING_BYTES;
constexpr int MISC_OFF = RING_BYTES + 4096;
constexpr int LDS_BYTES = 147456;

__device__ __forceinline__ int lane_id() { unsigned m = ~0u; asm volatile("" : "+s"(m)); return (int)__builtin_amdgcn_mbcnt_hi(m, __builtin_amdgcn_mbcnt_lo(m, 0u)); }
typedef __bf16 bf16x2_t __attribute__((ext_vector_type(2)));
__device__ __forceinline__ unsigned cvt_pk_bf16(float lo, float hi) { f32x2 v = {lo, hi}; bf16x2_t b = __builtin_convertvector(v, bf16x2_t); return __builtin_bit_cast(unsigned, b); }
__device__ __forceinline__ unsigned pk4_fp8(float a, float b, float c, float d) { int w = 0; w = __builtin_amdgcn_cvt_pk_fp8_f32(a, b, w, false); w = __builtin_amdgcn_cvt_pk_fp8_f32(c, d, w, true); return (unsigned)w; }
__device__ __forceinline__ float sat8(float v) { return __builtin_fminf(__builtin_fmaxf(v, -448.0f), 448.0f); }
__device__ __forceinline__ float bf_lo(unsigned w) { return __uint_as_float(w << 16); }
__device__ __forceinline__ float bf_hi(unsigned w) { return __uint_as_float(w & 0xffff0000u); }
__device__ __forceinline__ float bf2f(bf16 b) { return __uint_as_float((unsigned)b << 16); }
__device__ __forceinline__ bf16 f2bf(float f) { return (bf16)(cvt_pk_bf16(f, 0.f) & 0xffffu); }
__device__ __forceinline__ float fast_sigmoid(float x) { return __builtin_amdgcn_rcpf(1.0f + __builtin_amdgcn_exp2f(-x * LOG2E)); }
__device__ __forceinline__ float gelu_tanh(float x) { const float u = 0.7978845608028654f * (x + 0.044715f * x * x * x); return x * fast_sigmoid(2.0f * u); }
__device__ __forceinline__ float wave_sum(float v) {
#pragma unroll
    for (int o = 1; o < 64; o <<= 1) v += __shfl_xor(v, o);
    return v;
}
__device__ __forceinline__ v4u pack8(const f32x4 a, const f32x4 b) { v4u w; w.x = cvt_pk_bf16(a[0], a[1]); w.y = cvt_pk_bf16(a[2], a[3]); w.z = cvt_pk_bf16(b[0], b[1]); w.w = cvt_pk_bf16(b[2], b[3]); return w; }
__device__ __forceinline__ void unpack8(const v4u w, f32x4& a, f32x4& b) { a = (f32x4){bf_lo(w.x), bf_hi(w.x), bf_lo(w.y), bf_hi(w.y)}; b = (f32x4){bf_lo(w.z), bf_hi(w.z), bf_lo(w.w), bf_hi(w.w)}; }

#ifndef FP8_ASM_DMA
#define FP8_ASM_DMA 0
#endif
namespace pg8 {
constexpr int BM = 256, BK = 64, HALF = 128, HTB = HALF * BK * 2, STAGE_BYTES = 8 * HTB;
__host__ __device__ __forceinline__ int lds_byte(int r, int c) { const int st = (r >> 4) * 2 + (c >> 5), rr = r & 15, cc = c & 31, ob = rr * 64 + cc * 2; return st * 1024 + (ob ^ (((ob >> 9) & 1) << 5)); }
__host__ __device__ __forceinline__ void stage_rc(int b, int& R, int& C) { const int st = b / 1024, sb = b % 1024, swz = sb ^ (((sb >> 9) & 1) << 5); R = (st >> 1) * 16 + swz / 64; C = (st & 1) * 32 + (swz % 64) / 2; }
__host__ __device__ __forceinline__ int perm32(int rho) { const int n = rho >> 4, i = rho & 15; return 8 * (i >> 2) + 4 * n + (i & 3); }

__device__ __forceinline__ void glds16s(unsigned voff, const char* sbase, unsigned lds_dst) { unsigned keep;
    asm volatile("s_mov_b32 %0, m0\n\ts_mov_b32 m0, %3\n\ts_nop 0\n\tglobal_load_lds_dwordx4 %1, %2\n\ts_mov_b32 m0, %0" : "=&s"(keep) : "v"(voff), "s"(sbase), "s"(lds_dst) : "memory"); }
struct Unit { int pm, pn, tag, aux; const char* A; const char* B; };

template <class Epi, class Sched, bool ALIGN_EPI, bool GATHER, bool FP8 = false, bool MIX = false>
__device__ __forceinline__ void gemm_phase(LAS unsigned char* lds, const int wave_in, const int K, const int lda, const int ldb, const Sched& S, const Epi& E) {
    const int wid = wave_in, lane = lane_id(), tid = wid * 64 + lane,
              wr = wid >> 2, wc = wid & 3, fr = lane & 15, fq = lane >> 4;
    const int nt = K / BK;
    int Rr[2], Cc[2]; unsigned voffB[2], vA0[2], vA1[2], nA0[2], nA1[2];
#pragma unroll
    for (int i = 0; i < 2; ++i) { stage_rc(tid * 16 + i * 8192, Rr[i], Cc[i]); const int Rb = (Rr[i] & ~31) + perm32(Rr[i] & 31);
        voffB[i] = (unsigned)(Rb * ldb + Cc[i]) * 2u; vA0[i] = (unsigned)(Rr[i] * lda + Cc[i]) * 2u; vA1[i] = vA0[i]; nA0[i] = vA0[i]; nA1[i] = vA0[i]; }
    const size_t kstep = (size_t)(BK * 2);
    const size_t hstepA = GATHER ? (size_t)0 : (size_t)HALF * lda * 2, hstepB = (size_t)HALF * ldb * 2;
    const unsigned ldsw = (unsigned)wid * 1024u;
    const int sc1_ = 0x7F7F7F7F; (void)sc1_;
    const unsigned ldsb = (unsigned)(uintptr_t)lds; (void)ldsb;
    const int aoff = lds_byte(wr * 64 + fr, fq * 8), boff = lds_byte(wc * 32 + fr, fq * 8);
#define PG8_SA(b, h) (((b) * 2 + (h)) * HTB)
#define PG8_SB(b, h) ((4 + (b) * 2 + (h)) * HTB)
#define PG8_STAGE(bufoff, gbase, voff) do { _Pragma("unroll") for (int _i = 0; _i < 2; ++_i) { \
        if constexpr ((FP8 && FP8_ASM_DMA) || MIX) glds16s((voff)[_i], (const char*)(gbase), (unsigned)__builtin_amdgcn_readfirstlane((int)(ldsb + (unsigned)(bufoff) + ldsw + (unsigned)_i * 8192u))); \
        else __builtin_amdgcn_global_load_lds((const unsigned*)((const char*)(gbase) + (voff)[_i]), (LAS unsigned*)(lds + (bufoff) + ldsw + _i * 8192), 16, 0, 0); } } while (0)
#define PG8_LDA(dst, b, h) do { _Pragma("unroll") for (int m = 0; m < 4; ++m) _Pragma("unroll") for (int k = 0; k < 2; ++k) dst[m][k] = *(const LAS bf16x8*)(lds + PG8_SA(b, h) + aoff + m * 2048 + k * 1024); } while (0)
#define PG8_LDB(dst, b, h) do { _Pragma("unroll") for (int n = 0; n < 2; ++n) _Pragma("unroll") for (int k = 0; k < 2; ++k) dst[n][k] = *(const LAS bf16x8*)(lds + PG8_SB(b, h) + boff + n * 2048 + k * 1024); } while (0)
#define PG8_MMAX(F8, ai, bj, At, Bt) do { __builtin_amdgcn_s_setprio(1); _Pragma("unroll") for (int m = 0; m < 4; ++m) _Pragma("unroll") for (int n = 0; n < 2; ++n) { \
        if constexpr (F8) { const i32x4 b0_ = __builtin_bit_cast(i32x4, Bt[n][0]), b1_ = __builtin_bit_cast(i32x4, Bt[n][1]), a0_ = __builtin_bit_cast(i32x4, At[m][0]), a1_ = __builtin_bit_cast(i32x4, At[m][1]); \
            const i32x8 bv_ = {b0_[0], b0_[1], b0_[2], b0_[3], b1_[0], b1_[1], b1_[2], b1_[3]}, av_ = {a0_[0], a0_[1], a0_[2], a0_[3], a1_[0], a1_[1], a1_[2], a1_[3]}; \
            asm volatile("v_mfma_scale_f32_16x16x128_f8f6f4 %0, %1, %2, %0, %3, %3 op_sel_hi:[0,0,0]" : "+v"(acc[ai][bj][m][n]) : "v"(bv_), "v"(av_), "v"(sc1_)); } \
        else { _Pragma("unroll") for (int k = 0; k < 2; ++k) acc[ai][bj][m][n] = __builtin_amdgcn_mfma_f32_16x16x32_bf16(Bt[n][k], At[m][k], acc[ai][bj][m][n], 0, 0, 0); } } \
        __builtin_amdgcn_s_setprio(0); } while (0)
#define PG8_MMA(ai, bj, At, Bt) PG8_MMAX(FP8, ai, bj, At, Bt)
#define PG8_VA1 (GATHER ? vA1 : vA0)
#define PG8_S0 (GATHER ? s0 : vA0)
#define PG8_S1 (GATHER ? s1 : vA0)
#define PG8_WAIT_V(n) asm volatile("s_waitcnt vmcnt(" #n ")" ::: "memory")
#define PG8_WAIT_L(n) asm volatile("s_waitcnt lgkmcnt(" #n ")" ::: "memory")
#define PG8_BAR __builtin_amdgcn_s_barrier()
#define PG8_SCHED __builtin_amdgcn_sched_barrier(0)
#define PG8_KLOOP(F8, NTV) \
        for (int t = 0; t < (NTV); t += 2) { \
            const bool last = (t == (NTV) - 2); \
            const char* a1 = cA + (size_t)(t + 1) * kstep; \
            const char* a2 = last ? nA : cA + (size_t)(t + 2) * kstep; const char* b2 = last ? nB : cB + (size_t)(t + 2) * kstep; \
            const char* a3 = a2 + kstep; const char* b3 = b2 + kstep; \
            unsigned s0[2], s1[2]; \
            _Pragma("unroll") for (int i = 0; i < 2; ++i) { if constexpr (GATHER) { s0[i] = last ? nA0[i] : vA0[i]; s1[i] = last ? nA1[i] : vA1[i]; } else { s0[i] = vA0[i]; s1[i] = vA0[i]; } } \
            (void)s0; (void)s1; \
              \
            PG8_LDB(B0, 0, 0); PG8_LDB(B1, 0, 1); PG8_SCHED; PG8_LDA(At, 0, 0); PG8_STAGE(PG8_SA(1, 1), a1 + hstepA, PG8_VA1); \
            PG8_WAIT_V(8); PG8_WAIT_L(0); PG8_BAR; PG8_MMAX(F8, 0, 0, At, B0); PG8_MMAX(F8, 0, 1, At, B1); PG8_BAR; PG8_SCHED; \
            PG8_LDA(At, 0, 1); PG8_STAGE(PG8_SB(0, 0), b2, voffB); PG8_STAGE(PG8_SB(0, 1), b2 + hstepB, voffB); PG8_STAGE(PG8_SA(0, 0), a2, PG8_S0); \
            PG8_WAIT_V(8); PG8_WAIT_L(0); PG8_BAR; PG8_MMAX(F8, 1, 0, At, B0); PG8_MMAX(F8, 1, 1, At, B1); PG8_BAR; PG8_SCHED; \
              \
            PG8_LDB(B0, 1, 0); PG8_LDB(B1, 1, 1); PG8_SCHED; PG8_LDA(At, 1, 0); PG8_STAGE(PG8_SA(0, 1), a2 + hstepA, PG8_S1); \
            PG8_WAIT_V(8); PG8_WAIT_L(0); PG8_BAR; PG8_MMAX(F8, 0, 0, At, B0); PG8_MMAX(F8, 0, 1, At, B1); PG8_BAR; PG8_SCHED; \
            PG8_LDA(At, 1, 1); PG8_STAGE(PG8_SB(1, 0), b3, voffB); PG8_STAGE(PG8_SB(1, 1), b3 + hstepB, voffB); PG8_STAGE(PG8_SA(1, 0), a3, PG8_S0); \
            PG8_WAIT_V(8); PG8_WAIT_L(0); PG8_BAR; PG8_MMAX(F8, 1, 0, At, B0); PG8_MMAX(F8, 1, 1, At, B1); PG8_BAR; PG8_SCHED; \
        }
    Unit cur, nxt; int ui = 0;
    if (!S.next(0, cur)) return;
    if constexpr (GATHER) {
#pragma unroll
        for (int i = 0; i < 2; ++i) { vA0[i] = (unsigned)(S.grow(cur, Rr[i]) * lda + Cc[i]) * 2u; vA1[i] = (unsigned)(S.grow(cur, HALF + Rr[i]) * lda + Cc[i]) * 2u; }
    }
    f32x4 acc[2][2][4][2];
#pragma unroll
    for (int a = 0; a < 2; ++a)
#pragma unroll
        for (int b = 0; b < 2; ++b)
#pragma unroll
            for (int m = 0; m < 4; ++m)
#pragma unroll
                for (int n = 0; n < 2; ++n) acc[a][b][m][n] = (f32x4){0.f, 0.f, 0.f, 0.f};
    bf16x8 At[4][2], B0[2][2], B1[2][2];
    const char* cA = cur.A; const char* cB = cur.B;
    PG8_STAGE(PG8_SB(0, 0), cB, voffB); PG8_STAGE(PG8_SB(0, 1), cB + hstepB, voffB); PG8_STAGE(PG8_SA(0, 0), cA, vA0); PG8_STAGE(PG8_SA(0, 1), cA + hstepA, PG8_VA1);
    if (wr == 1) PG8_BAR;
    PG8_WAIT_V(2); PG8_BAR;
    PG8_STAGE(PG8_SB(1, 0), cB + kstep, voffB); PG8_STAGE(PG8_SA(1, 0), cA + kstep, vA0); PG8_STAGE(PG8_SB(1, 1), cB + hstepB + kstep, voffB);
    PG8_WAIT_V(6); PG8_BAR;
    for (;;) {
        const bool has_next = S.next(ui + 1, nxt);
        const char* nA = has_next ? nxt.A : cA; const char* nB = has_next ? nxt.B : cB;
        if constexpr (GATHER) {
            if (has_next) {
#pragma unroll
                for (int i = 0; i < 2; ++i) { nA0[i] = (unsigned)(S.grow(nxt, Rr[i]) * lda + Cc[i]) * 2u; nA1[i] = (unsigned)(S.grow(nxt, HALF + Rr[i]) * lda + Cc[i]) * 2u; }
            } else {
#pragma unroll
                for (int i = 0; i < 2; ++i) { nA0[i] = vA0[i]; nA1[i] = vA1[i]; }
            }
        }
        if constexpr (MIX) { if (cur.tag != 0) { PG8_KLOOP(true, nt >> 1); } else { PG8_KLOOP(false, nt); } }
        else { PG8_KLOOP(FP8, nt); }
        if constexpr (ALIGN_EPI) { if (wr == 0) PG8_BAR; }
        if constexpr (FP8 || MIX) asm volatile("s_nop 15\n\ts_nop 7" ::: "memory");
        if constexpr (!Epi::AFTER_DRAIN) { E(acc, cur, wr, wc, fr, fq); }
        if (!has_next) break;
#pragma unroll
        for (int a = 0; a < 2; ++a)
#pragma unroll
            for (int b = 0; b < 2; ++b)
#pragma unroll
                for (int m = 0; m < 4; ++m)
#pragma unroll
                    for (int n = 0; n < 2; ++n) acc[a][b][m][n] = (f32x4){0.f, 0.f, 0.f, 0.f};
        cur = nxt; cA = nA; cB = nB; ++ui;
        if constexpr (GATHER) {
#pragma unroll
            for (int i = 0; i < 2; ++i) { vA0[i] = nA0[i]; vA1[i] = nA1[i]; }
        }
        if constexpr (ALIGN_EPI) { if (wr == 1) PG8_BAR; }
    }
    PG8_WAIT_V(0);
    if constexpr (!ALIGN_EPI) { if (wr == 0) PG8_BAR; }
    PG8_BAR;
    if constexpr (Epi::AFTER_DRAIN) { E.fused(acc, cur, wr, wc, fr, fq, lds, wid, lane); }
#undef PG8_SA
#undef PG8_SB
#undef PG8_STAGE
#undef PG8_LDA
#undef PG8_LDB
#undef PG8_MMA
#undef PG8_MMAX
#undef PG8_KLOOP
#undef PG8_VA1
#undef PG8_S0
#undef PG8_S1
#undef PG8_WAIT_V
#undef PG8_WAIT_L
#undef PG8_BAR
#undef PG8_SCHED
}
}
typedef f32x4 Acc[2][2][4][2];

__device__ __forceinline__ float ssq16(const float* p) { const f32x4 a = *(const f32x4*)p, b = *(const f32x4*)(p + 4), c = *(const f32x4*)(p + 8), d = *(const f32x4*)(p + 12);
    return (((a[0] + a[1]) + (a[2] + a[3])) + ((b[0] + b[1]) + (b[2] + b[3]))) + (((c[0] + c[1]) + (c[2] + c[3])) + ((d[0] + d[1]) + (d[2] + d[3]))); }
struct SchedGrid2 {
    int G, c; int n0, nN0, nN1, ntot; const char *A0, *B0, *A1, *B1; size_t ta, tb; bool xcd;
    __device__ __forceinline__ bool next(int i, pg8::Unit& u) const {
        if (xcd) {
            const int x = c >> 5, q = i * 32 + (c & 31); if (q >= 16 * nN0) return false;
            const int g8 = q / (8 * nN0), r = q % (8 * nN0);
            u.pm = 16 * x + 8 * g8 + (r & 7); u.pn = r >> 3; u.tag = 0; u.aux = 0; u.A = A0 + (size_t)u.pm * ta; u.B = B0 + (size_t)u.pn * tb; return true;
        }
        int L = i * G + c; if (L >= ntot) return false;
        if (L < n0) { u.pm = L / nN0; u.pn = L % nN0; u.tag = 0; u.A = A0 + (size_t)u.pm * ta; u.B = B0 + (size_t)u.pn * tb; }
        else { L -= n0; u.pm = L / nN1; u.pn = L % nN1; u.tag = 1; u.A = A1 + (size_t)u.pm * ta; u.B = B1 + (size_t)u.pn * tb; }
        u.aux = 0; return true;
    }
    __device__ __forceinline__ int grow(const pg8::Unit&, int) const { return 0; }
};
__device__ __forceinline__ SchedGrid2 make_grid1(int G, int c, int nM, int nN, const void* A, const void* B, int lda, int ldb) {
    SchedGrid2 s; s.G = G; s.c = c; s.n0 = nM * nN; s.nN0 = nN; s.nN1 = 1; s.ntot = s.n0; s.A0 = (const char*)A; s.B0 = (const char*)B; s.A1 = s.A0; s.B1 = s.B0;
    s.ta = (size_t)256 * lda * 2; s.tb = (size_t)256 * ldb * 2; s.xcd = (G == 256 && nM == 128); return s;
}
__device__ __forceinline__ SchedGrid2 make_grid2(int G, int c, int nM0, int nN0, const void* A0, const void* B0, int nM1, int nN1, const void* A1, const void* B1, int lda, int ldb) {
    SchedGrid2 s; s.G = G; s.c = c; s.n0 = nM0 * nN0; s.nN0 = nN0; s.nN1 = nN1; s.ntot = s.n0 + nM1 * nN1; s.A0 = (const char*)A0; s.B0 = (const char*)B0; s.A1 = (const char*)A1; s.B1 = (const char*)B1;
    s.ta = (size_t)256 * lda * 2; s.tb = (size_t)256 * ldb * 2; s.xcd = false; return s;
}
struct SchedBranch {
    int G, c; const char *ws;
    __device__ __forceinline__ bool next(int i, pg8::Unit& u) const {
        const int j = i % 3, b = 2 - j; int pm, pn;
        if (G == 256) { const int x = c >> 5, q = (i / 3) * 32 + (c & 31); if (q >= 64) return false; const int g8 = q >> 5, r = q & 31; pm = 16 * x + 8 * g8 + (r & 7); pn = r >> 3; }
        else { const int tile = (i / 3) * G + c; if (tile >= (T / 256) * 4) return false; pm = tile >> 2; pn = tile & 3; }
        u.pm = pm; u.pn = pn; u.tag = b; u.aux = j;
        const size_t yo = b == 0 ? WS_GL : (b == 1 ? WS_YB : WS_YC8);
        u.A = ws + yo + (size_t)u.pm * 256 * 512 * 2; u.B = ws + WS_WBR + ((size_t)b * 1024 + u.pn * 256) * 512 * 2; return true;
    }
    __device__ __forceinline__ int grow(const pg8::Unit&, int) const { return 0; }
};
struct MoeTab { const LAS int* p;
    __device__ __forceinline__ int cnt(int e) const { return p[e]; }
    __device__ __forceinline__ int base(int e) const { return p[32 + e]; }
    __device__ __forceinline__ int ntile() const { return p[64]; }
    __device__ __forceinline__ int tile_e(int t) const { return p[128 + t]; }
    __device__ __forceinline__ int tile_r(int t) const { return p[128 + MAXTILES + t]; }
};
template <int NCOL, bool GATHERED>
struct SchedMoe {
    int G, c; MoeTab tab; const char* Abase; const char* Wbase; size_t wexp, wtile; const int* ltok;
    __device__ __forceinline__ bool next(int i, pg8::Unit& u) const {
        const int L = i * G + c, rt = L / NCOL; if (rt >= tab.ntile()) return false;
        const int e = tab.tile_e(rt), r = tab.tile_r(rt);
        u.pn = L % NCOL; u.tag = e; u.aux = r; u.pm = (tab.base(e) >> 8) + r;
        u.A = GATHERED ? Abase : Abase + (size_t)u.pm * 256 * DEXP;
        u.B = Wbase + (size_t)e * wexp + (size_t)u.pn * wtile; return true;
    }
    __device__ __forceinline__ int grow(const pg8::Unit& u, int r) const {
        const int p = u.aux * 256 + r; return p < tab.cnt(u.tag) ? ltok[u.tag * T + p] : 0;
    }
};

#define EPI_ROWS_BEGIN _Pragma("unroll") for (int ai = 0; ai < 2; ++ai) _Pragma("unroll") for (int m = 0; m < 4; ++m) { const int row = u.pm * 256 + ai * 128 + wr * 64 + m * 16 + fr;
#define EPI_ROWS_END }

struct EpiProj {
    static constexpr bool AFTER_DRAIN = false;
    bf16 *XL, *GL, *CQ, *CKV, *QM, *SG, *KB; float *ssq_q, *ssq_kv; const float *cosT, *sinT; bool side; int pn_off; float gscale;
    __device__ __forceinline__ void operator()(const Acc& acc, const pg8::Unit& u, int wr, int wc, int fr, int fq) const {
        const int pn = u.pn + pn_off, cl = wc * 32 + 8 * fq;
        if (PROBE_SKIP == 9 && side) {
            unsigned char* const tb = (unsigned char*)XL + ((size_t)(u.pm * 8 + pn) << 17) + (wr * 4 + wc) * 16384 + (fq * 16 + fr) * 16;
            EPI_ROWS_BEGIN
#pragma unroll
                for (int bj = 0; bj < 2; ++bj) *(v4u*)(tb + ((ai * 4 + m) * 2 + bj) * 1024) = pack8(acc[ai][bj][m][0], acc[ai][bj][m][1]); (void)row; EPI_ROWS_END
            return;
        }
        if (PROBE_SKIP == 10 && side) {
            EPI_ROWS_BEGIN
#pragma unroll
                for (int bj = 0; bj < 2; ++bj) *(v4u*)(XL + ((size_t)(u.pm * 8 + pn) << 16) + (size_t)(row & 255) * 256 + bj * 128 + cl) = pack8(acc[ai][bj][m][0], acc[ai][bj][m][1]); EPI_ROWS_END
            return;
        }
        if (PROBE_SKIP && PROBE_SKIP != 4 && PROBE_SKIP < 6 && side) return;
        if (DBG_OUT == 2) {
            EPI_ROWS_BEGIN
#pragma unroll
                for (int bj = 0; bj < 2; ++bj) *(v4u*)(XL + (size_t)row * 5120 + pn * 256 + bj * 128 + cl) = pack8(acc[ai][bj][m][0], acc[ai][bj][m][1]); EPI_ROWS_END
        } else if (pn < 2) {
            EPI_ROWS_BEGIN
#pragma unroll
                for (int bj = 0; bj < 2; ++bj) *(v4u*)(XL + (size_t)row * 512 + pn * 256 + bj * 128 + cl) = pack8(acc[ai][bj][m][0], acc[ai][bj][m][1]); EPI_ROWS_END
        } else if (pn < 4) {
            EPI_ROWS_BEGIN
#pragma unroll
                for (int bj = 0; bj < 2; ++bj) { f32x4 a = acc[ai][bj][m][0], b = acc[ai][bj][m][1];
#pragma unroll
                    for (int j = 0; j < 4; ++j) { a[j] = gelu_tanh(a[j]); b[j] = gelu_tanh(b[j]); }
                    *(v4u*)(GL + (size_t)row * 512 + (pn - 2) * 256 + bj * 128 + cl) = pack8(a, b); } EPI_ROWS_END
        } else if (pn == 4) {
            EPI_ROWS_BEGIN
                float s = 0.f;
#pragma unroll
                for (int bj = 0; bj < 2; ++bj) { const f32x4 a = acc[ai][bj][m][0] * gscale, b = acc[ai][bj][m][1] * gscale;
                    s += (a[0] * a[0] + a[1] * a[1]) + (a[2] * a[2] + a[3] * a[3]) + (b[0] * b[0] + b[1] * b[1]) + (b[2] * b[2] + b[3] * b[3]);
                    { v2u c8; c8.x = pk4_fp8(sat8(a[0] * CL8_SCALE), sat8(a[1] * CL8_SCALE), sat8(a[2] * CL8_SCALE), sat8(a[3] * CL8_SCALE)); c8.y = pk4_fp8(sat8(b[0] * CL8_SCALE), sat8(b[1] * CL8_SCALE), sat8(b[2] * CL8_SCALE), sat8(b[3] * CL8_SCALE));
                      *(v2u*)((unsigned char*)CQ + (size_t)row * 256 + bj * 128 + cl) = c8; } }
                s += __shfl_xor(s, 16); s += __shfl_xor(s, 32);
                if (fq == 0) ssq_q[row * 4 + wc] = s; EPI_ROWS_END
        } else if (pn == 5) {
            EPI_ROWS_BEGIN
                { const f32x4 a = acc[ai][0][m][0] * gscale, b = acc[ai][0][m][1] * gscale;
                  float s = (a[0] * a[0] + a[1] * a[1]) + (a[2] * a[2] + a[3] * a[3]) + (b[0] * b[0] + b[1] * b[1]) + (b[2] * b[2] + b[3] * b[3]);
                  { const f32x4 a1 = acc[ai][1][m][0] * gscale, b1 = acc[ai][1][m][1] * gscale; v2u c8;
                    c8.x = pk4_fp8(sat8(a[0] * CL8_SCALE), sat8(a[1] * CL8_SCALE), sat8(a[2] * CL8_SCALE), sat8(a[3] * CL8_SCALE)); c8.y = pk4_fp8(sat8(b[0] * CL8_SCALE), sat8(b[1] * CL8_SCALE), sat8(b[2] * CL8_SCALE), sat8(b[3] * CL8_SCALE));
                    *(v2u*)((unsigned char*)CKV + (size_t)row * 256 + cl) = c8;
                    c8.x = pk4_fp8(sat8(a1[0] * CL8_SCALE), sat8(a1[1] * CL8_SCALE), sat8(a1[2] * CL8_SCALE), sat8(a1[3] * CL8_SCALE)); c8.y = pk4_fp8(sat8(b1[0] * CL8_SCALE), sat8(b1[1] * CL8_SCALE), sat8(b1[2] * CL8_SCALE), sat8(b1[3] * CL8_SCALE));
                    *(v2u*)((unsigned char*)CKV + (size_t)row * 256 + 128 + cl) = c8; }
                  s += __shfl_xor(s, 16); s += __shfl_xor(s, 32);
                  if (fq == 0) ssq_kv[row * 4 + wc] = s; }
                if (wc == 0) {
                    const f32x4 a = acc[ai][1][m][0] * gscale, b = acc[ai][1][m][1] * gscale;
                    const f32x4 cs = *(const f32x4*)(cosT + (size_t)row * 16 + 4 * fq), sn = *(const f32x4*)(sinT + (size_t)row * 16 + 4 * fq);
                    f32x4 oa, ob;
                    oa[0] = a[0] * cs[0] - a[1] * sn[0]; oa[1] = a[1] * cs[0] + a[0] * sn[0]; oa[2] = a[2] * cs[1] - a[3] * sn[1]; oa[3] = a[3] * cs[1] + a[2] * sn[1];
                    ob[0] = b[0] * cs[2] - b[1] * sn[2]; ob[1] = b[1] * cs[2] + b[0] * sn[2]; ob[2] = b[2] * cs[3] - b[3] * sn[3]; ob[3] = b[3] * cs[3] + b[2] * sn[3];
                    *(v4u*)(KB + (size_t)row * 32 + 8 * fq) = pack8(oa, ob);
                } EPI_ROWS_END
        } else if (pn < 8) {
            EPI_ROWS_BEGIN
#pragma unroll
                for (int bj = 0; bj < 2; ++bj) *(v4u*)(QM + (size_t)row * 512 + (pn - 6) * 256 + bj * 128 + cl) = pack8(acc[ai][bj][m][0] * (C2_MEM * gscale), acc[ai][bj][m][1] * (C2_MEM * gscale)); EPI_ROWS_END
        } else {
            unsigned char* const sgl = (unsigned char*)SG + ((size_t)(u.pm * 12 + pn - 8) << 16);
            const unsigned lo = (unsigned)((((wr * 4 + wc) * 16) * 64 + fq * 16 + fr) << 3); const float gneg = -gscale * LOG2E;
            EPI_ROWS_BEGIN
#pragma unroll
                for (int bj = 0; bj < 2; ++bj) { f32x4 a = acc[ai][bj][m][0], b = acc[ai][bj][m][1];
#pragma unroll
                    for (int j = 0; j < 4; ++j) { a[j] = __builtin_amdgcn_rcpf(1.0f + __builtin_amdgcn_exp2f(a[j] * gneg)) * 255.0f + 0.5f; b[j] = __builtin_amdgcn_rcpf(1.0f + __builtin_amdgcn_exp2f(b[j] * gneg)) * 255.0f + 0.5f; }
                    unsigned o = lo; asm volatile("" : "+v"(o)); unsigned char* const sp = sgl + o;
                    v2u w; w.x = (unsigned)a[0] | ((unsigned)a[1] << 8) | ((unsigned)a[2] << 16) | ((unsigned)a[3] << 24); w.y = (unsigned)b[0] | ((unsigned)b[1] << 8) | ((unsigned)b[2] << 16) | ((unsigned)b[3] << 24);
                    *(v2u*)(sp + ((ai * 4 + m) * 2 + bj) * 512) = w; (void)row; } EPI_ROWS_END
        }
    }
};
struct EpiGate {
    static constexpr bool AFTER_DRAIN = false;
    unsigned char* SG; float gscale; bool skip;
    __device__ __forceinline__ void operator()(const Acc& acc, const pg8::Unit& u, int wr, int wc, int fr, int fq) const {
        if (PROBE_SKIP && PROBE_SKIP < 5 && skip) return;
        unsigned char* const sgl = SG + ((size_t)(u.pm * 12 + u.pn) << 16);
        const unsigned lo = (unsigned)((((wr * 4 + wc) * 16) * 64 + fq * 16 + fr) << 3); const float gneg = -gscale * LOG2E;
#pragma unroll
        for (int ai = 0; ai < 2; ++ai)
#pragma unroll
            for (int m = 0; m < 4; ++m)
#pragma unroll
                for (int bj = 0; bj < 2; ++bj) { f32x4 a = acc[ai][bj][m][0], b = acc[ai][bj][m][1];
#pragma unroll
                    for (int j = 0; j < 4; ++j) { a[j] = __builtin_amdgcn_rcpf(1.0f + __builtin_amdgcn_exp2f(a[j] * gneg)) * 255.0f + 0.5f; b[j] = __builtin_amdgcn_rcpf(1.0f + __builtin_amdgcn_exp2f(b[j] * gneg)) * 255.0f + 0.5f; }
                    unsigned o = lo; asm volatile("" : "+v"(o));
                    v2u w; w.x = (unsigned)a[0] | ((unsigned)a[1] << 8) | ((unsigned)a[2] << 16) | ((unsigned)a[3] << 24); w.y = (unsigned)b[0] | ((unsigned)b[1] << 8) | ((unsigned)b[2] << 16) | ((unsigned)b[3] << 24);
                    *(v2u*)(sgl + o + ((ai * 4 + m) * 2 + bj) * 512) = w; }
    }
};
struct EpiQ {
    static constexpr bool AFTER_DRAIN = false;
    bf16* Q; const float* ssq_q; const float *cosT, *sinT;
    __device__ __forceinline__ void operator()(const Acc& acc, const pg8::Unit& u, int wr, int wc, int fr, int fq) const {
        const int cl = wc * 32 + 8 * fq;
        EPI_ROWS_BEGIN
            const f32x4 sq4 = *(const f32x4*)(ssq_q + row * 4); const float rs = rsqrtf(((sq4[0] + sq4[1]) + (sq4[2] + sq4[3])) * (1.0f / 256.0f) + EPS) * (1.0f / (WU8_SCALE * CL8_SCALE));
#pragma unroll
            for (int bj = 0; bj < 2; ++bj) { const int c = u.pn * 256 + bj * 128 + cl, d = c % 96;
                f32x4 a = acc[ai][bj][m][0] * rs, b = acc[ai][bj][m][1] * rs;
                if (d >= 64) { const int i0 = (d - 64) >> 1;
                    const f32x4 cs = *(const f32x4*)(cosT + (size_t)row * 16 + i0), sn = *(const f32x4*)(sinT + (size_t)row * 16 + i0);
                    f32x4 oa, ob;
                    oa[0] = a[0] * cs[0] - a[1] * sn[0]; oa[1] = a[1] * cs[0] + a[0] * sn[0]; oa[2] = a[2] * cs[1] - a[3] * sn[1]; oa[3] = a[3] * cs[1] + a[2] * sn[1];
                    ob[0] = b[0] * cs[2] - b[1] * sn[2]; ob[1] = b[1] * cs[2] + b[0] * sn[2]; ob[2] = b[2] * cs[3] - b[3] * sn[3]; ob[3] = b[3] * cs[3] + b[2] * sn[3];
                    a = oa; b = ob; }
                *(v4u*)(Q + (size_t)row * 768 + c) = pack8(a * C2_MLA, b * C2_MLA); } EPI_ROWS_END
    }
};
struct EpiKV {
    static constexpr bool AFTER_DRAIN = false;
    bf16 *KB, *VT; const float* ssq_kv;
    __device__ __forceinline__ void operator()(const Acc& acc, const pg8::Unit& u, int wr, int wc, int fr, int fq) const {
        const int cl = wc * 32 + 8 * fq;
        if (u.tag == 0) {
            EPI_ROWS_BEGIN
                const f32x4 sq4 = *(const f32x4*)(ssq_kv + row * 4); const float rs = rsqrtf(((sq4[0] + sq4[1]) + (sq4[2] + sq4[3])) * (1.0f / 128.0f) + EPS) * (1.0f / (WU8_SCALE * CL8_SCALE));
#pragma unroll
                for (int bj = 0; bj < 2; ++bj) { const int c = u.pn * 256 + bj * 128 + cl;
                    *(v4u*)(KB + (size_t)row * 512 + c) = pack8(acc[ai][bj][m][0] * rs, acc[ai][bj][m][1] * rs); } EPI_ROWS_END
        } else {
            f32x4 rsa[2], rsb[2]; size_t cb[2];
#pragma unroll
            for (int bj = 0; bj < 2; ++bj) { const int t0 = u.pn * 256 + bj * 128 + cl;
#pragma unroll
                for (int j = 0; j < 4; ++j) { const f32x4 qa = *(const f32x4*)(ssq_kv + (t0 + j) * 4), qb = *(const f32x4*)(ssq_kv + (t0 + 4 + j) * 4);
                    rsa[bj][j] = rsqrtf(((qa[0] + qa[1]) + (qa[2] + qa[3])) * (1.0f / 128.0f) + EPS) * (1.0f / (WU8_SCALE * CL8_SCALE)); rsb[bj][j] = rsqrtf(((qb[0] + qb[1]) + (qb[2] + qb[3])) * (1.0f / 128.0f) + EPS) * (1.0f / (WU8_SCALE * CL8_SCALE)); }
                cb[bj] = (size_t)(t0 >> 12) * 512 * 4096 + (t0 & 4095); }
            EPI_ROWS_BEGIN
#pragma unroll
                for (int bj = 0; bj < 2; ++bj) *(v4u*)(VT + cb[bj] + (size_t)row * 4096) = pack8(acc[ai][bj][m][0] * rsa[bj], acc[ai][bj][m][1] * rsb[bj]); EPI_ROWS_END
        }
    }
};
struct EpiMem {
    static constexpr bool AFTER_DRAIN = false;
    bf16 *MK, *MVT;
    __device__ __forceinline__ void operator()(const Acc& acc, const pg8::Unit& u, int wr, int wc, int fr, int fq) const {
        const int cl = wc * 32 + 8 * fq;
        if (u.tag == 0) {
            EPI_ROWS_BEGIN
#pragma unroll
                for (int bj = 0; bj < 2; ++bj) *(v4u*)(MK + (size_t)row * 512 + u.pn * 256 + bj * 128 + cl) = pack8(acc[ai][bj][m][0], acc[ai][bj][m][1]); EPI_ROWS_END
        } else {
            EPI_ROWS_BEGIN
#pragma unroll
                for (int bj = 0; bj < 2; ++bj) *(v4u*)(MVT + ((size_t)u.pn * 512 + row) * 256 + bj * 128 + cl) = pack8(acc[ai][bj][m][0], acc[ai][bj][m][1]); EPI_ROWS_END
        }
    }
};
struct EpiBranch {
    static constexpr bool AFTER_DRAIN = false;
    const bf16* SG; bf16* MG;
    mutable v2u hold[16];
    template <int ST>
    __device__ __forceinline__ void stage(const Acc& acc, const pg8::Unit& u, int wr, int wc, int fr_, int fq_) const {
        constexpr int b = 2 - ST;
        const int ln = lane_id(); (void)fr_; (void)fq_;
        const int fr = ln & 15, fq = ln >> 4, cl = wc * 32 + 8 * fq;
        const size_t lb = (size_t)((((wr * 4 + wc) * 16) * 64 + fq * 16 + fr) << 3);
        const unsigned char* const gl = (const unsigned char*)SG + ((size_t)(u.pm * 12 + b * 4 + u.pn) << 16) + lb;
        constexpr float q = b ? (1.0f / 255.0f) / (WB8_SCALE * Y8_SCALE) : 1.0f / 255.0f;
#pragma unroll
        for (int ai = 0; ai < 2; ++ai) {
            v2u gw[4][2];
#pragma unroll
            for (int m = 0; m < 4; ++m)
#pragma unroll
                for (int bj = 0; bj < 2; ++bj) gw[m][bj] = *(const v2u*)(gl + ((ai * 4 + m) * 2 + bj) * 512);
#pragma unroll
            for (int m = 0; m < 4; ++m) { const int row = u.pm * 256 + ai * 128 + wr * 64 + m * 16 + fr;
#pragma unroll
                for (int bj = 0; bj < 2; ++bj) { const int c = u.pn * 256 + bj * 128 + cl, k = (ai * 4 + m) * 2 + bj;
                    f32x4 ga, gb;
                    { const unsigned g0 = gw[m][bj].x, g1 = gw[m][bj].y;
                      ga = (f32x4){(float)(g0 & 255u) * q, (float)((g0 >> 8) & 255u) * q, (float)((g0 >> 16) & 255u) * q, (float)(g0 >> 24) * q};
                      gb = (f32x4){(float)(g1 & 255u) * q, (float)((g1 >> 8) & 255u) * q, (float)((g1 >> 16) & 255u) * q, (float)(g1 >> 24) * q}; }
                    f32x4 a = acc[ai][bj][m][0] * ga, bb = acc[ai][bj][m][1] * gb;
                    if (!((DBG_BR >> b) & 1)) { a = (f32x4){0.f, 0.f, 0.f, 0.f}; bb = a; }
                    if constexpr (ST > 0) { const f32x2 h0 = __builtin_amdgcn_cvt_pk_f32_fp8((int)hold[k].x, false), h1 = __builtin_amdgcn_cvt_pk_f32_fp8((int)hold[k].x, true), h2 = __builtin_amdgcn_cvt_pk_f32_fp8((int)hold[k].y, false), h3 = __builtin_amdgcn_cvt_pk_f32_fp8((int)hold[k].y, true);
                        a += (f32x4){h0[0], h0[1], h1[0], h1[1]}; bb += (f32x4){h2[0], h2[1], h3[0], h3[1]}; }
                    if constexpr (ST < 2) { hold[k].x = pk4_fp8(a[0], a[1], a[2], a[3]); hold[k].y = pk4_fp8(bb[0], bb[1], bb[2], bb[3]); }
                    else *(v4u*)(MG + (size_t)row * 1024 + c) = pack8(a, bb); } }
        }
    }
    __device__ __forceinline__ void operator()(const Acc& acc, const pg8::Unit& u, int wr, int wc, int fr, int fq) const {
        if (u.aux == 0) stage<0>(acc, u, wr, wc, fr, fq); else if (u.aux == 1) stage<1>(acc, u, wr, wc, fr, fq); else stage<2>(acc, u, wr, wc, fr, fq);
    }
};
struct EpiWo {
    static constexpr bool AFTER_DRAIN = false;
    const float* x; float* out; bf16* HB; float* ssq_h; bool side; unsigned char* HB8;
    __device__ __forceinline__ void operator()(const Acc& acc, const pg8::Unit& u, int wr, int wc, int fr, int fq) const {
        const int cl = wc * 32 + 8 * fq;
        f32x4 xa[2][2][2], xb[2][2][2];
#define WO_LOAD(k) do { _Pragma("unroll") for (int mm = 0; mm < 2; ++mm) _Pragma("unroll") for (int bj = 0; bj < 2; ++bj) { \
            const size_t off = (size_t)(u.pm * 256 + ((k) >> 1) * 128 + wr * 64 + (((k) & 1) * 2 + mm) * 16 + fr) * 1024 + u.pn * 256 + bj * 128 + cl; \
            xa[(k) & 1][mm][bj] = *(const f32x4*)(x + off); xb[(k) & 1][mm][bj] = *(const f32x4*)(x + off + 4); } } while (0)
        WO_LOAD(0);
#pragma unroll
        for (int k = 0; k < 4; ++k) { const int ai = k >> 1, mh = k & 1;
                if (k < 3) WO_LOAD(k + 1);
#pragma unroll
                for (int mm = 0; mm < 2; ++mm) { const int m = mh * 2 + mm, row = u.pm * 256 + ai * 128 + wr * 64 + m * 16 + fr; float s = 0.f;
#pragma unroll
                    for (int bj = 0; bj < 2; ++bj) { const size_t off = (size_t)row * 1024 + u.pn * 256 + bj * 128 + cl;
                        const f32x4 a = xa[k & 1][mm][bj] + acc[ai][bj][m][0], b = xb[k & 1][mm][bj] + acc[ai][bj][m][1];
                        *(v4u*)(HB + off) = pack8(a, b); { v2u h8; h8.x = pk4_fp8(a[0], a[1], a[2], a[3]); h8.y = pk4_fp8(b[0], b[1], b[2], b[3]); *(v2u*)(HB8 + off) = h8; }
                        s += (a[0] * a[0] + a[1] * a[1]) + (a[2] * a[2] + a[3] * a[3]) + (b[0] * b[0] + b[1] * b[1]) + (b[2] * b[2] + b[3] * b[3]); }
                    s += __shfl_xor(s, 16); s += __shfl_xor(s, 32);
                    if (fq == 0) ssq_h[row * 16 + u.pn * 4 + wc] = s; }
        }
#undef WO_LOAD
    }
};
struct EpiRouter {
    static constexpr bool AFTER_DRAIN = true;
    const float* ssq_h; const float *b_group, *b_router; unsigned* gcnt; int* ltok; float* lw; int* pick; float* rsh;
    __device__ __forceinline__ void fused(Acc& acc, const pg8::Unit& u, int wr, int wc, int fr, int fq, LAS unsigned char* lds, int wid, int lane) const {
        LAS unsigned* lcnt = (LAS unsigned*)lds; LAS unsigned* lbase = lcnt + 32;
        const int tix = wid * 64 + lane;
        if (tix < 32) lcnt[tix] = 0u;
        __syncthreads();
        int pe0[8], pe1[8], pp0[8], pp1[8]; float pw0[8], pw1[8];
        if (wc == 0) {
            const f32x4 bg = *(const f32x4*)b_group;
#pragma unroll
            for (int ai = 0; ai < 2; ++ai)
#pragma unroll
                for (int m = 0; m < 4; ++m) {
                    const int row = u.pm * 256 + ai * 128 + wr * 64 + m * 16 + fr, k = ai * 4 + m;
                    const float rs = rsqrtf(ssq16(ssq_h + row * 16) * (1.0f / 1024.0f) + EPS);
                    if (fq == 0) rsh[row] = rs;
                    const f32x4 gl = acc[ai][1][m][0] * rs + bg;
                    int g = 0; float gm = gl[0];
#pragma unroll
                    for (int j = 1; j < 4; ++j) if (gl[j] > gm) { gm = gl[j]; g = j; }
                    float den = 0.f;
#pragma unroll
                    for (int j = 0; j < 4; ++j) den += __expf(gl[j] - gm);
                    float gwt = 1.0f / den;
                    g = __shfl(g, fr); gwt = __shfl(gwt, fr);
                    const f32x4 ba = *(const f32x4*)(b_router + 8 * fq), bb = *(const f32x4*)(b_router + 8 * fq + 4);
                    const f32x4 la = acc[ai][0][m][0] * rs + ba, lb = acc[ai][0][m][1] * rs + bb;
                    float v[8] = {la[0], la[1], la[2], la[3], lb[0], lb[1], lb[2], lb[3]};
                    int i1 = 0; float v1 = v[0];
#pragma unroll
                    for (int j = 1; j < 8; ++j) if (v[j] > v1) { v1 = v[j]; i1 = j; }
                    int i2 = -1; float v2 = -INFINITY;
#pragma unroll
                    for (int j = 0; j < 8; ++j) if (j != i1 && v[j] > v2) { v2 = v[j]; i2 = j; }
                    const float w1 = gwt / (1.0f + __expf(v2 - v1)), w2 = gwt - w1;
                    pe0[k] = -1; pe1[k] = -1; pp0[k] = 0; pp1[k] = 0; pw0[k] = w1; pw1[k] = w2;
                    if (fq == g) { pe0[k] = 8 * g + i1; pe1[k] = 8 * g + i2;
                        pp0[k] = (int)__hip_atomic_fetch_add(lcnt + pe0[k], 1u, __ATOMIC_RELAXED, __HIP_MEMORY_SCOPE_WORKGROUP);
                        pp1[k] = (int)__hip_atomic_fetch_add(lcnt + pe1[k], 1u, __ATOMIC_RELAXED, __HIP_MEMORY_SCOPE_WORKGROUP); }
                }
        }
        __syncthreads();
        if (tix < 32) { const unsigned n = lcnt[tix]; lbase[tix] = n ? __hip_atomic_fetch_add(gcnt + tix, n, RLX_AGENT) : 0u; }
        __syncthreads();
        if (wc == 0) {
#pragma unroll
            for (int ai = 0; ai < 2; ++ai)
#pragma unroll
                for (int m = 0; m < 4; ++m) {
                    const int row = u.pm * 256 + ai * 128 + wr * 64 + m * 16 + fr, k = ai * 4 + m;
                    if (pe0[k] >= 0) {
                        const int e0 = pe0[k], e1 = pe1[k], s0 = (int)lbase[e0] + pp0[k], s1 = (int)lbase[e1] + pp1[k];
                        ltok[e0 * T + s0] = row; lw[e0 * T + s0] = pw0[k]; ltok[e1 * T + s1] = row; lw[e1 * T + s1] = pw1[k];
                        pick[row * 2] = (e0 << 16) | s0; pick[row * 2 + 1] = (e1 << 16) | s1;
                    }
                }
        }
    }
};
struct EpiE1 {
    static constexpr bool AFTER_DRAIN = false;
    const float* rsh; const int* ltok; bf16* HD; MoeTab tab;
    __device__ __forceinline__ void operator()(const Acc& acc, const pg8::Unit& u, int wr, int wc, int fr, int fq) const {
        const int cl = wc * 32 + 8 * fq, e = u.tag, cnt = tab.cnt(e);
        const int ln = lane_id();
        unsigned char* const hdl = (unsigned char*)HD + (size_t)(u.pm * 256 + wr * 64 + (ln & 15)) * 256 + u.pn * 128 + wc * 32 + 8 * (ln >> 4);
        int tok[8]; float sq[8];
#pragma unroll
        for (int k = 0; k < 8; ++k) { const int p = u.aux * 256 + (k >> 2) * 128 + wr * 64 + (k & 3) * 16 + fr; tok[k] = p < cnt ? ltok[e * T + p] : 0; }
#pragma unroll
        for (int k = 0; k < 8; ++k) sq[k] = rsh[tok[k]];
        EPI_ROWS_BEGIN
            const int p = u.aux * 256 + ai * 128 + wr * 64 + m * 16 + fr;
            if (p < cnt) { const float rs = sq[ai * 4 + m] * (1.0f / W18_SCALE);
                f32x4 a, b;
#pragma unroll
                for (int j = 0; j < 4; ++j) { const float g0 = acc[ai][0][m][0][j] * rs, u0 = acc[ai][1][m][0][j] * rs, g1 = acc[ai][0][m][1][j] * rs, u1 = acc[ai][1][m][1][j] * rs;
                    a[j] = g0 * fast_sigmoid(g0) * u0; b[j] = g1 * fast_sigmoid(g1) * u1; }
                v2u h8; h8.x = pk4_fp8(sat8(a[0] * HD8_SCALE), sat8(a[1] * HD8_SCALE), sat8(a[2] * HD8_SCALE), sat8(a[3] * HD8_SCALE)); h8.y = pk4_fp8(sat8(b[0] * HD8_SCALE), sat8(b[1] * HD8_SCALE), sat8(b[2] * HD8_SCALE), sat8(b[3] * HD8_SCALE));
                *(v2u*)(hdl + (size_t)(ai * 128 + m * 16) * 256) = h8; (void)row; } EPI_ROWS_END
    }
};
struct EpiE2 {
    static constexpr bool AFTER_DRAIN = false;
    const float* lw; unsigned char* YE; MoeTab tab;
    __device__ __forceinline__ void operator()(const Acc& acc, const pg8::Unit& u, int wr, int wc, int fr, int fq) const {
        const int cl = wc * 32 + 8 * fq, e = u.tag, cnt = tab.cnt(e);
        EPI_ROWS_BEGIN
            const int p = u.aux * 256 + ai * 128 + wr * 64 + m * 16 + fr;
            if (p < cnt) { const float w = lw[e * T + p] * (1.0f / (W28_SCALE * HD8_SCALE));
#pragma unroll
                for (int bj = 0; bj < 2; ++bj) { const f32x4 a = acc[ai][bj][m][0] * w, b = acc[ai][bj][m][1] * w; v2u y8; y8.x = pk4_fp8(a[0], a[1], a[2], a[3]); y8.y = pk4_fp8(b[0], b[1], b[2], b[3]);
                    *(v2u*)(YE + (size_t)row * 1024 + u.pn * 256 + bj * 128 + cl) = y8; } } EPI_ROWS_END
    }
};

namespace att {
__device__ __forceinline__ float pmax(float m) { auto rr = __builtin_amdgcn_permlane32_swap(__float_as_uint(m), __float_as_uint(m), false, false); return fmaxf(__uint_as_float(rr[0]), __uint_as_float(rr[1])); }
__device__ __forceinline__ float psum(float m) { auto rr = __builtin_amdgcn_permlane32_swap(__float_as_uint(m), __float_as_uint(m), false, false); return __uint_as_float(rr[0]) + __uint_as_float(rr[1]); }
template <int DQK, int DV, bool CAUSAL, bool O8 = false>
__device__ __forceinline__ void unit(LAS unsigned char* lds, const int wave_in, const bf16* Qp, int qp, const bf16* Kp, int kp, const bf16* Vp, int vp, bf16* Op, int op, int q0, int NT) {
    constexpr int KST = DQK * 2 + 16, VST = 144, KBUF = 64 * KST, VBUF = DV * VST;
    constexpr int NCK = DQK / 8, TOTK = 64 * NCK, TOTV = DV * 8, NKI = (TOTK + 511) / 512, NVI = (TOTV + 511) / 512, ND0 = DQK / 16, NDT = DV / 32;
    const int wid = wave_in, lane = lane_id(), tid = wid * 64 + lane, r32 = lane & 31, hi = lane >> 5;
    const bf16* ksrc[NKI]; int kdst[NKI]; bool kval[NKI]; const bf16* vsrc[NVI]; int vdst[NVI];
#pragma unroll
    for (int i = 0; i < NKI; ++i) { const int id = tid + 512 * i; kval[i] = id < TOTK; const int idc = kval[i] ? id : 0, kr = idc / NCK, j = idc % NCK;
        const int rho = (kr & ~12) | ((kr & 4) << 1) | ((kr & 8) >> 1);
        ksrc[i] = Kp + (size_t)kr * kp + 8 * j; kdst[i] = rho * KST + 16 * j; }
#pragma unroll
    for (int i = 0; i < NVI; ++i) { const int id = tid + 512 * i, d = id >> 3, j = id & 7; vsrc[i] = Vp + (size_t)d * vp + 8 * j; vdst[i] = d * VST + 16 * j; }
    v4u kreg[NKI], vreg[NVI];
#define ATT_LOAD(t) do { _Pragma("unroll") for (int i = 0; i < NKI; ++i) kreg[i] = kval[i] ? *(const v4u*)(ksrc[i] + (size_t)(t) * 64 * kp) : (v4u){0u, 0u, 0u, 0u}; \
                         _Pragma("unroll") for (int i = 0; i < NVI; ++i) vreg[i] = *(const v4u*)(vsrc[i] + (size_t)(t) * 64); } while (0)
#define ATT_STORE(b) do { _Pragma("unroll") for (int i = 0; i < NKI; ++i) if (kval[i]) *(LAS v4u*)(lds + (b) * KBUF + kdst[i]) = kreg[i]; \
                          _Pragma("unroll") for (int i = 0; i < NVI; ++i) *(LAS v4u*)(lds + 2 * KBUF + (b) * VBUF + vdst[i]) = vreg[i]; } while (0)
    ATT_LOAD(0);
    bf16x8 qr[ND0];
    { const bf16* qrow = Qp + (size_t)(32 * wid + r32) * qp + hi * 8;
#pragma unroll
      for (int d0 = 0; d0 < ND0; ++d0) qr[d0] = *(const bf16x8*)(qrow + d0 * 16); }
    ATT_STORE(0);
    __syncthreads();
    f32x16 o[NDT];
#pragma unroll
    for (int dt = 0; dt < NDT; ++dt)
#pragma unroll
        for (int r = 0; r < 16; ++r) o[dt][r] = 0.f;
    float mrun = -INFINITY, lsum = 0.f;
    const int qbase = q0 + 32 * wid, qrow_i = qbase + r32;
    for (int t = 0; t < NT; ++t) {
        const int b = t & 1;
        if (t + 1 < NT) ATT_LOAD(t + 1);
        if (!CAUSAL || 64 * t <= qbase + 31) {
            const LAS unsigned char* kb = lds + b * KBUF + r32 * KST + hi * 16;
            f32x16 p0, p1;
#pragma unroll
            for (int r = 0; r < 16; ++r) { p0[r] = 0.f; p1[r] = 0.f; }
#pragma unroll
            for (int d0 = 0; d0 < ND0; ++d0) {
                const bf16x8 a0 = *(const LAS bf16x8*)(kb + d0 * 32), a1 = *(const LAS bf16x8*)(kb + 32 * KST + d0 * 32);
                p0 = __builtin_amdgcn_mfma_f32_32x32x16_bf16(a0, qr[d0], p0, 0, 0, 0);
                p1 = __builtin_amdgcn_mfma_f32_32x32x16_bf16(a1, qr[d0], p1, 0, 0, 0);
                if (DQK > 96 && (d0 & 1)) __builtin_amdgcn_sched_barrier(0);
            }
            if (CAUSAL && 64 * t + 63 > qbase) {
#pragma unroll
                for (int r = 0; r < 16; ++r) { const int key = 64 * t + 16 * (r >> 3) + 8 * hi + (r & 7);
                    if (key > qrow_i) p0[r] = -INFINITY; if (key + 32 > qrow_i) p1[r] = -INFINITY; }
            }
            float mt = fmaxf(p0[0], p1[0]);
#pragma unroll
            for (int r = 1; r < 16; ++r) mt = fmaxf(mt, fmaxf(p0[r], p1[r]));
            mt = pmax(mt);
            const float mnew = fmaxf(mrun, mt), sc = __builtin_amdgcn_exp2f(mrun - mnew);
            mrun = mnew;
            float ps = 0.f;
#pragma unroll
            for (int r = 0; r < 16; ++r) { p0[r] = __builtin_amdgcn_exp2f(p0[r] - mnew); p1[r] = __builtin_amdgcn_exp2f(p1[r] - mnew); ps += p0[r] + p1[r]; }
            lsum = lsum * sc + ps;
#pragma unroll
            for (int dt = 0; dt < NDT; ++dt)
#pragma unroll
                for (int r = 0; r < 16; ++r) o[dt][r] *= sc;
            bf16x8 pf[4];
            { v4u w;
              w.x = cvt_pk_bf16(p0[0], p0[1]); w.y = cvt_pk_bf16(p0[2], p0[3]); w.z = cvt_pk_bf16(p0[4], p0[5]); w.w = cvt_pk_bf16(p0[6], p0[7]); pf[0] = __builtin_bit_cast(bf16x8, w);
              w.x = cvt_pk_bf16(p0[8], p0[9]); w.y = cvt_pk_bf16(p0[10], p0[11]); w.z = cvt_pk_bf16(p0[12], p0[13]); w.w = cvt_pk_bf16(p0[14], p0[15]); pf[1] = __builtin_bit_cast(bf16x8, w);
              w.x = cvt_pk_bf16(p1[0], p1[1]); w.y = cvt_pk_bf16(p1[2], p1[3]); w.z = cvt_pk_bf16(p1[4], p1[5]); w.w = cvt_pk_bf16(p1[6], p1[7]); pf[2] = __builtin_bit_cast(bf16x8, w);
              w.x = cvt_pk_bf16(p1[8], p1[9]); w.y = cvt_pk_bf16(p1[10], p1[11]); w.z = cvt_pk_bf16(p1[12], p1[13]); w.w = cvt_pk_bf16(p1[14], p1[15]); pf[3] = __builtin_bit_cast(bf16x8, w); }
            const LAS unsigned char* vb = lds + 2 * KBUF + b * VBUF + r32 * VST + hi * 16;
#pragma unroll
            for (int dt = 0; dt < NDT; ++dt)
#pragma unroll
                for (int s = 0; s < 4; ++s) {
                    const bf16x8 vf = *(const LAS bf16x8*)(vb + dt * 32 * VST + s * 32);
                    o[dt] = __builtin_amdgcn_mfma_f32_32x32x16_bf16(vf, pf[s], o[dt], 0, 0, 0);
                    if (DV > 64 && s == 3) __builtin_amdgcn_sched_barrier(0);
                }
        }
        if (t + 1 < NT) ATT_STORE(b ^ 1);
        __syncthreads();
    }
    const float lt = psum(lsum), inv = 1.0f / lt;
    if constexpr (O8) {
        unsigned char* orow8 = (unsigned char*)Op + (size_t)(32 * wid + r32) * op + 4 * hi; const float i8 = inv * Y8_SCALE;
#pragma unroll
        for (int dt = 0; dt < NDT; ++dt)
#pragma unroll
            for (int g = 0; g < 4; ++g) *(unsigned*)(orow8 + 32 * dt + 8 * g) = pk4_fp8(sat8(o[dt][4 * g] * i8), sat8(o[dt][4 * g + 1] * i8), sat8(o[dt][4 * g + 2] * i8), sat8(o[dt][4 * g + 3] * i8));
    } else {
    bf16* orow = Op + (size_t)(32 * wid + r32) * op + 4 * hi;
#pragma unroll
    for (int dt = 0; dt < NDT; ++dt)
#pragma unroll
        for (int g = 0; g < 4; ++g) { v2u w; w.x = cvt_pk_bf16(o[dt][4 * g] * inv, o[dt][4 * g + 1] * inv); w.y = cvt_pk_bf16(o[dt][4 * g + 2] * inv, o[dt][4 * g + 3] * inv);
            *(v2u*)(orow + 32 * dt + 8 * g) = w; }
    }
#undef ATT_LOAD
#undef ATT_STORE
}
__device__ __forceinline__ float max3f(float a, float b, float c) { float r; asm("v_max3_f32 %0, %1, %2, %3" : "=v"(r) : "v"(a), "v"(b), "v"(c)); return r; }
template <int DQK, int DV, bool CAUSAL, int VARIANT = 0>
__device__ __forceinline__ void unit_f(LAS unsigned char* lds, const int wave_in, const bf16* Qp, int qp, const bf16* Kp, int kp, const bf16* Vp, int vp, bf16* Op, int op, int q0, int NT) {
    constexpr int KST = DQK * 2 + 16, VST = 144, KBUF = 64 * KST, VBUF = DV * VST;
    constexpr int NCK = DQK / 8, TOTV = DV * 8, NVI = (TOTV + 511) / 512, ND0 = DQK / 16, NDT = DV / 32;
    static_assert(NCK > 8 && NCK <= 16, "unit_f: K rows of 9..16 chunks");
    const int wid = wave_in, lane = lane_id(), tid = wid * 64 + lane, r32 = lane & 31, hi = lane >> 5;
    const int krow = tid >> 3, kj = tid & 7; const bool kval1 = kj + 8 < NCK;
    const int rho = (krow & ~12) | ((krow & 4) << 1) | ((krow & 8) >> 1);
    const bf16* ksrc0 = Kp + (size_t)krow * kp + 8 * kj; const int kdst0 = rho * KST + 16 * kj;
    const bf16* vsrc[NVI]; int vdst[NVI];
#pragma unroll
    for (int i = 0; i < NVI; ++i) { const int id = tid + 512 * i, d = id >> 3, j = id & 7; vsrc[i] = Vp + (size_t)d * vp + 8 * j; vdst[i] = d * VST + 16 * j; }
    v4u kregA[2], vregA[NVI], kregB[2], vregB[NVI];
#define ATF_LOAD(KR, VR, t) do { KR[0] = *(const v4u*)(ksrc0 + (size_t)(t) * 64 * kp); KR[1] = kval1 ? *(const v4u*)(ksrc0 + (size_t)(t) * 64 * kp + 64) : (v4u){0u, 0u, 0u, 0u}; \
                         _Pragma("unroll") for (int i = 0; i < NVI; ++i) VR[i] = *(const v4u*)(vsrc[i] + (size_t)(t) * 64); } while (0)
#define ATF_STORE(KR, VR, b) do { *(LAS v4u*)(lds + (b) * KBUF + kdst0) = KR[0]; if (kval1) *(LAS v4u*)(lds + (b) * KBUF + kdst0 + 128) = KR[1]; \
                          _Pragma("unroll") for (int i = 0; i < NVI; ++i) *(LAS v4u*)(lds + 2 * KBUF + (b) * VBUF + vdst[i]) = VR[i]; } while (0)
    ATF_LOAD(kregA, vregA, 0);
    if (NT > 1) ATF_LOAD(kregB, vregB, 1);
    bf16x8 qr[ND0];
    { const bf16* qrow = Qp + (size_t)(32 * wid + r32) * qp + hi * 8;
#pragma unroll
      for (int d0 = 0; d0 < ND0; ++d0) qr[d0] = *(const bf16x8*)(qrow + d0 * 16); }
    ATF_STORE(kregA, vregA, 0);
    __syncthreads();
    f32x16 o[NDT];
#pragma unroll
    for (int dt = 0; dt < NDT; ++dt)
#pragma unroll
        for (int r = 0; r < 16; ++r) o[dt][r] = 0.f;
    float mrun = 0.f, lsum = 0.f;
    f32x16 negm;
#pragma unroll
    for (int r = 0; r < 16; ++r) negm[r] = 0.f;
    const int qbase = q0 + 32 * wid, qrow_i = qbase + r32;
#define ATF_ITER(t, LK, LV, SK, SV) do { const int b = (t) & 1; \
        if (VARIANT != 3 && (t) + 2 < NT) ATF_LOAD(LK, LV, (t) + 2); \
        if (!CAUSAL || 64 * t <= qbase + 31) { \
            const LAS unsigned char* kb = lds + b * KBUF + r32 * KST + hi * 16; \
            f32x16 p0 = negm, p1 = negm; \
            _Pragma("unroll") \
            for (int d0 = 0; d0 < ND0; ++d0) { \
                const bf16x8 a0 = *(const LAS bf16x8*)(kb + d0 * 32), a1 = *(const LAS bf16x8*)(kb + 32 * KST + d0 * 32); \
                if (VARIANT != 2) { p0 = __builtin_amdgcn_mfma_f32_32x32x16_bf16(a0, qr[d0], p0, 0, 0, 0); \
                p1 = __builtin_amdgcn_mfma_f32_32x32x16_bf16(a1, qr[d0], p1, 0, 0, 0); } else { p0[d0] += __builtin_bit_cast(float, (int)a0[0]); p1[d0] += __builtin_bit_cast(float, (int)a1[0]); } \
            } \
            asm volatile("s_nop 15\n\ts_nop 7" : "+v"(p0), "+v"(p1)); \
            if (CAUSAL && 64 * t + 63 > qbase) { \
            _Pragma("unroll") \
                for (int r = 0; r < 16; ++r) { const int key = 64 * t + 16 * (r >> 3) + 8 * hi + (r & 7); \
                    if (key > qrow_i) p0[r] = -INFINITY; if (key + 32 > qrow_i) p1[r] = -INFINITY; } \
            } \
            if (VARIANT != 1) { \
            float mt = max3f(p0[0], p1[0], p0[1]), mu = max3f(p1[1], p0[2], p1[2]); \
            _Pragma("unroll") \
            for (int r = 3; r < 15; r += 2) { mt = max3f(mt, p0[r], p1[r]); mu = max3f(mu, p0[r + 1], p1[r + 1]); } \
            mt = pmax(max3f(mt, mu, fmaxf(p0[15], p1[15]))); \
            if (__any(t == 0 || mt > 8.0f)) { \
                const float dl = (t == 0) ? mt : fmaxf(mt, 0.f), sc = __builtin_amdgcn_exp2f(-dl); \
                mrun += dl; lsum *= sc; \
            _Pragma("unroll") \
                for (int r = 0; r < 16; ++r) { p0[r] -= dl; p1[r] -= dl; negm[r] = -mrun; } \
            _Pragma("unroll") \
                for (int dt = 0; dt < NDT; ++dt) \
            _Pragma("unroll") \
                    for (int r = 0; r < 16; ++r) o[dt][r] *= sc; \
            } \
            float ps0 = 0.f, ps1 = 0.f; \
            _Pragma("unroll") \
            for (int r = 0; r < 16; ++r) { p0[r] = __builtin_amdgcn_exp2f(p0[r]); p1[r] = __builtin_amdgcn_exp2f(p1[r]); ps0 += p0[r]; ps1 += p1[r]; } \
            lsum += ps0 + ps1; } \
            bf16x8 pf[4]; \
            { v4u w; \
              w.x = cvt_pk_bf16(p0[0], p0[1]); w.y = cvt_pk_bf16(p0[2], p0[3]); w.z = cvt_pk_bf16(p0[4], p0[5]); w.w = cvt_pk_bf16(p0[6], p0[7]); pf[0] = __builtin_bit_cast(bf16x8, w); \
              w.x = cvt_pk_bf16(p0[8], p0[9]); w.y = cvt_pk_bf16(p0[10], p0[11]); w.z = cvt_pk_bf16(p0[12], p0[13]); w.w = cvt_pk_bf16(p0[14], p0[15]); pf[1] = __builtin_bit_cast(bf16x8, w); \
              w.x = cvt_pk_bf16(p1[0], p1[1]); w.y = cvt_pk_bf16(p1[2], p1[3]); w.z = cvt_pk_bf16(p1[4], p1[5]); w.w = cvt_pk_bf16(p1[6], p1[7]); pf[2] = __builtin_bit_cast(bf16x8, w); \
              w.x = cvt_pk_bf16(p1[8], p1[9]); w.y = cvt_pk_bf16(p1[10], p1[11]); w.z = cvt_pk_bf16(p1[12], p1[13]); w.w = cvt_pk_bf16(p1[14], p1[15]); pf[3] = __builtin_bit_cast(bf16x8, w); } \
            const LAS unsigned char* vb = lds + 2 * KBUF + b * VBUF + r32 * VST + hi * 16; \
            _Pragma("unroll") \
            for (int dt = 0; dt < NDT; ++dt) \
            _Pragma("unroll") \
                for (int s = 0; s < 4; ++s) { \
                    const bf16x8 vf = *(const LAS bf16x8*)(vb + dt * 32 * VST + s * 32); \
                    if (VARIANT != 2) o[dt] = __builtin_amdgcn_mfma_f32_32x32x16_bf16(vf, pf[s], o[dt], 0, 0, 0); else o[dt][s] += __builtin_bit_cast(float, (int)vf[0]) + __builtin_bit_cast(float, (int)pf[s][0]); \
                } \
        } \
        if (VARIANT != 3 && (t) + 1 < NT) ATF_STORE(SK, SV, b ^ 1); \
        __syncthreads(); } while (0)
    for (int t = 0; t < NT; t += 2) {
        ATF_ITER(t, kregA, vregA, kregB, vregB);
        const int t1 = t + 1;
        if (t1 < NT) ATF_ITER(t1, kregB, vregB, kregA, vregA);
    }
#undef ATF_ITER
    const float lt = psum(lsum), inv = 1.0f / lt;
    bf16* orow = Op + (size_t)(32 * wid + r32) * op + 4 * hi;
#pragma unroll
    for (int dt = 0; dt < NDT; ++dt)
#pragma unroll
        for (int g = 0; g < 4; ++g) { v2u w; w.x = cvt_pk_bf16(o[dt][4 * g] * inv, o[dt][4 * g + 1] * inv); w.y = cvt_pk_bf16(o[dt][4 * g + 2] * inv, o[dt][4 * g + 3] * inv);
            *(v2u*)(orow + 32 * dt + 8 * g) = w; }
#undef ATF_LOAD
#undef ATF_STORE
}

template <int DQK, int DV, bool O8 = false>
__device__ __forceinline__ void unit_g(LAS unsigned char* lds, const int wave_in, const bf16* Qp, int qp, const bf16* Kp, int kp, const bf16* Krp, int krp, const bf16* Vp, int vp, bf16* Op, int op, int q0, int NT) {
    constexpr int KST = DQK * 2 + 16, VST = 144, KBUF = 64 * KST, VBUF = DV * VST;
    constexpr int NCK = DQK / 8, TOTV = DV * 8, NVI = (TOTV + 511) / 512, ND0 = DQK / 16, NDT = DV / 32;
    static_assert(NCK > 8 && NCK <= 16, "unit_g: K rows of 9..16 chunks");
    const int wid = wave_in, lane = lane_id(), tid = wid * 64 + lane, r32 = lane & 31, hi = lane >> 5;
    const int krow = tid >> 3, kj = tid & 7; const bool kval1 = kj + 8 < NCK;
    const int rho = (krow & ~12) | ((krow & 4) << 1) | ((krow & 8) >> 1);
    const bf16* ksrc0 = Kp + (size_t)krow * kp + 8 * kj; const bf16* ksrc1 = Krp + (size_t)krow * krp + 8 * kj; const int kdst0 = rho * KST + 16 * kj;
    const bf16* vsrc[NVI]; int vdst[NVI];
#pragma unroll
    for (int i = 0; i < NVI; ++i) { const int id = tid + 512 * i, d = id >> 3, j = id & 7; vsrc[i] = Vp + (size_t)d * vp + 8 * j; vdst[i] = d * VST + 16 * j; }
    v4u kreg[2], vreg[NVI];
#define ATG_LOAD(t) do { kreg[0] = *(const v4u*)(ksrc0 + (size_t)(t) * 64 * kp); kreg[1] = kval1 ? *(const v4u*)(ksrc1 + (size_t)(t) * 64 * krp) : (v4u){0u, 0u, 0u, 0u}; \
                         _Pragma("unroll") for (int i = 0; i < NVI; ++i) vreg[i] = *(const v4u*)(vsrc[i] + (size_t)(t) * 64); } while (0)
#define ATG_STORE(b) do { *(LAS v4u*)(lds + (b) * KBUF + kdst0) = kreg[0]; if (kval1) *(LAS v4u*)(lds + (b) * KBUF + kdst0 + 128) = kreg[1]; \
                          _Pragma("unroll") for (int i = 0; i < NVI; ++i) *(LAS v4u*)(lds + 2 * KBUF + (b) * VBUF + vdst[i]) = vreg[i]; } while (0)
    ATG_LOAD(0);
    bf16x8 qa[ND0], qb[ND0];
    { const bf16* qrow = Qp + (size_t)(64 * wid + r32) * qp + hi * 8;
#pragma unroll
      for (int d0 = 0; d0 < ND0; ++d0) { qa[d0] = *(const bf16x8*)(qrow + d0 * 16); qb[d0] = *(const bf16x8*)(qrow + (size_t)32 * qp + d0 * 16); } }
    ATG_STORE(0);
    __syncthreads();
    f32x16 oa[NDT], ob[NDT];
#pragma unroll
    for (int dt = 0; dt < NDT; ++dt)
#pragma unroll
        for (int r = 0; r < 16; ++r) { oa[dt][r] = 0.f; ob[dt][r] = 0.f; }
    float ma = 0.f, mb = 0.f, la = 0.f, lb = 0.f;
    const int tdiag = (q0 >> 6) + wid, qrel = r32;
#define ATG_SOFTMAX(P0, P1, M, L, O, PF) do { \
        float mt_ = max3f(P0[0], P1[0], P0[1]), mu_ = max3f(P1[1], P0[2], P1[2]); \
        _Pragma("unroll") for (int r = 3; r < 15; r += 2) { mt_ = max3f(mt_, P0[r], P1[r]); mu_ = max3f(mu_, P0[r + 1], P1[r + 1]); } \
        mt_ = pmax(max3f(mt_, mu_, fmaxf(P0[15], P1[15]))); \
        if (__any(t == 0 || mt_ > M + 8.0f)) { const float dl_ = (t == 0) ? mt_ - M : fmaxf(mt_ - M, 0.f), sc_ = __builtin_amdgcn_exp2f(-dl_); M += dl_; L *= sc_; \
            _Pragma("unroll") for (int dt = 0; dt < NDT; ++dt) _Pragma("unroll") for (int r = 0; r < 16; ++r) O[dt][r] *= sc_; } \
        float s0_ = 0.f, s1_ = 0.f; \
        _Pragma("unroll") for (int r = 0; r < 16; ++r) { P0[r] = __builtin_amdgcn_exp2f(P0[r] - M); P1[r] = __builtin_amdgcn_exp2f(P1[r] - M); s0_ += P0[r]; s1_ += P1[r]; } \
        L += s0_ + s1_; \
        { v4u w_; \
          w_.x = cvt_pk_bf16(P0[0], P0[1]); w_.y = cvt_pk_bf16(P0[2], P0[3]); w_.z = cvt_pk_bf16(P0[4], P0[5]); w_.w = cvt_pk_bf16(P0[6], P0[7]); PF[0] = __builtin_bit_cast(bf16x8, w_); \
          w_.x = cvt_pk_bf16(P0[8], P0[9]); w_.y = cvt_pk_bf16(P0[10], P0[11]); w_.z = cvt_pk_bf16(P0[12], P0[13]); w_.w = cvt_pk_bf16(P0[14], P0[15]); PF[1] = __builtin_bit_cast(bf16x8, w_); \
          w_.x = cvt_pk_bf16(P1[0], P1[1]); w_.y = cvt_pk_bf16(P1[2], P1[3]); w_.z = cvt_pk_bf16(P1[4], P1[5]); w_.w = cvt_pk_bf16(P1[6], P1[7]); PF[2] = __builtin_bit_cast(bf16x8, w_); \
          w_.x = cvt_pk_bf16(P1[8], P1[9]); w_.y = cvt_pk_bf16(P1[10], P1[11]); w_.z = cvt_pk_bf16(P1[12], P1[13]); w_.w = cvt_pk_bf16(P1[14], P1[15]); PF[3] = __builtin_bit_cast(bf16x8, w_); } } while (0)
    for (int t = 0; t < NT; ++t) {
        const int b = t & 1;
        if (t + 1 < NT) ATG_LOAD(t + 1);
        if (t <= tdiag) {
            const LAS unsigned char* kb = lds + b * KBUF + r32 * KST + hi * 16;
            f32x16 pa0, pa1, pb0, pb1;
#pragma unroll
            for (int r = 0; r < 16; ++r) { pa0[r] = 0.f; pa1[r] = 0.f; pb0[r] = 0.f; pb1[r] = 0.f; }
#pragma unroll
            for (int d0 = 0; d0 < ND0; ++d0) {
                const bf16x8 a0 = *(const LAS bf16x8*)(kb + d0 * 32), a1 = *(const LAS bf16x8*)(kb + 32 * KST + d0 * 32);
                pa0 = __builtin_amdgcn_mfma_f32_32x32x16_bf16(a0, qa[d0], pa0, 0, 0, 0); pa1 = __builtin_amdgcn_mfma_f32_32x32x16_bf16(a1, qa[d0], pa1, 0, 0, 0);
                pb0 = __builtin_amdgcn_mfma_f32_32x32x16_bf16(a0, qb[d0], pb0, 0, 0, 0); pb1 = __builtin_amdgcn_mfma_f32_32x32x16_bf16(a1, qb[d0], pb1, 0, 0, 0);
            }
            asm volatile("s_nop 15\n\ts_nop 7" : "+v"(pa0), "+v"(pa1), "+v"(pb0), "+v"(pb1));
            if (t == tdiag) {
#pragma unroll
                for (int r = 0; r < 16; ++r) { const int kk = 16 * (r >> 3) + 8 * hi + (r & 7);
                    if (kk > qrel) pa0[r] = -INFINITY; pa1[r] = -INFINITY; if (kk > qrel) pb1[r] = -INFINITY; }
            }
            bf16x8 pfa[4], pfb[4];
            ATG_SOFTMAX(pa0, pa1, ma, la, oa, pfa);
            ATG_SOFTMAX(pb0, pb1, mb, lb, ob, pfb);
            const LAS unsigned char* vb = lds + 2 * KBUF + b * VBUF + r32 * VST + hi * 16;
#pragma unroll
            for (int dt = 0; dt < NDT; ++dt)
#pragma unroll
                for (int s = 0; s < 4; ++s) {
                    const bf16x8 vf = *(const LAS bf16x8*)(vb + dt * 32 * VST + s * 32);
                    oa[dt] = __builtin_amdgcn_mfma_f32_32x32x16_bf16(vf, pfa[s], oa[dt], 0, 0, 0);
                    ob[dt] = __builtin_amdgcn_mfma_f32_32x32x16_bf16(vf, pfb[s], ob[dt], 0, 0, 0);
                }
        }
        if (t + 1 < NT) ATG_STORE(b ^ 1);
        __syncthreads();
    }
    const float ia = 1.0f / psum(la), ib = 1.0f / psum(lb);
    const int lane_e = lane_id();
    if constexpr (O8) {
        unsigned char* orow8 = (unsigned char*)Op + (size_t)(64 * wid + (lane_e & 31)) * op + 4 * (lane_e >> 5); const float ia8 = ia * Y8_SCALE, ib8 = ib * Y8_SCALE;
#pragma unroll
        for (int dt = 0; dt < NDT; ++dt)
#pragma unroll
            for (int g = 0; g < 4; ++g) {
                *(unsigned*)(orow8 + 32 * dt + 8 * g) = pk4_fp8(sat8(oa[dt][4 * g] * ia8), sat8(oa[dt][4 * g + 1] * ia8), sat8(oa[dt][4 * g + 2] * ia8), sat8(oa[dt][4 * g + 3] * ia8));
                *(unsigned*)(orow8 + (size_t)32 * op + 32 * dt + 8 * g) = pk4_fp8(sat8(ob[dt][4 * g] * ib8), sat8(ob[dt][4 * g + 1] * ib8), sat8(ob[dt][4 * g + 2] * ib8), sat8(ob[dt][4 * g + 3] * ib8)); }
    } else {
    bf16* orow = Op + (size_t)(64 * wid + (lane_e & 31)) * op + 4 * (lane_e >> 5);
#pragma unroll
    for (int dt = 0; dt < NDT; ++dt)
#pragma unroll
        for (int g = 0; g < 4; ++g) { v2u w; w.x = cvt_pk_bf16(oa[dt][4 * g] * ia, oa[dt][4 * g + 1] * ia); w.y = cvt_pk_bf16(oa[dt][4 * g + 2] * ia, oa[dt][4 * g + 3] * ia);
            *(v2u*)(orow + 32 * dt + 8 * g) = w;
            w.x = cvt_pk_bf16(ob[dt][4 * g] * ib, ob[dt][4 * g + 1] * ib); w.y = cvt_pk_bf16(ob[dt][4 * g + 2] * ib, ob[dt][4 * g + 3] * ib);
            *(v2u*)(orow + (size_t)32 * op + 32 * dt + 8 * g) = w; }
    }
#undef ATG_LOAD
#undef ATG_STORE
#undef ATG_SOFTMAX
}
}

#define XB_TMO      128
#define XB_XCNT(j)  (256  + 64 * (j))
#define XB_XSUB(j)  (1280 + 64 * (j))
#define XB_XGEN(j)  (2304 + 64 * (j))
#define XB_TOP      3328
#define XB_TOPGEN   3392
#define XCD_BAR_WORDS 3456
#define XB_SPIN_CAP (1u << 18)
__device__ __forceinline__ unsigned xb_ld(unsigned* p)              { return __hip_atomic_load(p, __ATOMIC_RELAXED, __HIP_MEMORY_SCOPE_AGENT); }
__device__ __forceinline__ unsigned xb_add(unsigned* p, unsigned v) { return __hip_atomic_fetch_add(p, v, __ATOMIC_RELAXED, __HIP_MEMORY_SCOPE_AGENT); }
__device__ __forceinline__ unsigned xb_xcc_id() { return (unsigned)__builtin_amdgcn_s_getreg((3 << 11) | 20) & 0xFu; }
#define XB_SPIN(cond, bar) do { unsigned _sp = 0; while (cond) { __builtin_amdgcn_s_sleep(1); \
    if ((++_sp & 255u) == 0u) { if (xb_ld(&(bar)[XB_TMO])) break; if (_sp > XB_SPIN_CAP) { atomicAdd(&(bar)[XB_TMO], 1u); break; } } } } while (0)
struct XcdBarrier { unsigned* bar; unsigned x; volatile LAS unsigned* st; int wave; };
__device__ __forceinline__ XcdBarrier xcd_barrier_post(unsigned* bar, volatile LAS unsigned* st, int wave) {
    XcdBarrier b; b.bar = bar; b.x = xb_xcc_id(); b.st = st; b.wave = wave;
    if (wave == 0 && lane_id() == 0) (void)xb_add(&bar[XB_XCNT(b.x)], 1u);
    return b;
}
__device__ __forceinline__ void xcd_barrier_complete(unsigned* bar, unsigned x, unsigned& nloc, unsigned& nx) {
    const unsigned G = gridDim.x * gridDim.y * gridDim.z;
    unsigned sum, cnt, mine, sp = 0u;
    for (;;) {
        sum = 0u; cnt = 0u; mine = 0u;
#pragma unroll
        for (unsigned j = 0; j < 16; ++j) { const unsigned c = xb_ld(&bar[XB_XCNT(j)]); sum += c; cnt += (c > 0u) ? 1u : 0u; mine = (j == x) ? c : mine; }
        if (sum == G) break;
        __builtin_amdgcn_s_sleep(1);
        if ((++sp & 255u) == 0u) { if (xb_ld(&bar[XB_TMO])) break; if (sp > XB_SPIN_CAP) { atomicAdd(&bar[XB_TMO], 1u); break; } }
    }
    nloc = mine > 0u ? mine : 1u; nx = cnt > 0u ? cnt : 1u;
}
__device__ __forceinline__ void xcd_barrier(const XcdBarrier& b) {
    asm volatile("s_waitcnt vmcnt(0)" ::: "memory");
    __syncthreads();
    if (b.wave == 0 && lane_id() == 0) {
        unsigned* bar = b.bar;
        __builtin_amdgcn_s_waitcnt(0);
        unsigned nloc = b.st[0], nx = b.st[1];
        if (nloc == 0u) { xcd_barrier_complete(bar, b.x, nloc, nx); b.st[0] = nloc; b.st[1] = nx; }
        const unsigned old = xb_add(&bar[XB_XSUB(b.x)], 1u);
        const unsigned gen = old / nloc;
        if (old + 1u == (gen + 1u) * nloc) {
            __builtin_amdgcn_fence(__ATOMIC_RELEASE, "agent");
            asm volatile("s_waitcnt vmcnt(0)" ::: "memory");
            const unsigned og = xb_add(&bar[XB_TOP], 1u);
            const unsigned tg = og / nx;
            if (og + 1u == (tg + 1u) * nx) xb_add(&bar[XB_TOPGEN], 1u);
            else XB_SPIN(xb_ld(&bar[XB_TOPGEN]) == tg, bar);
            __builtin_amdgcn_fence(__ATOMIC_ACQUIRE, "agent");
            xb_add(&bar[XB_XGEN(b.x)], 1u);
            asm volatile("s_waitcnt vmcnt(0)" ::: "memory");
        } else {
            XB_SPIN(xb_ld(&bar[XB_XGEN(b.x)]) == gen, bar);
            __builtin_amdgcn_fence(__ATOMIC_ACQUIRE, "agent");
            asm volatile("s_waitcnt vmcnt(0)" ::: "memory");
        }
    }
    __syncthreads();
}

struct Args { const void* in[29]; float* out; unsigned char* ws; int ph_lo, ph_hi; };
struct Frame {
    LAS unsigned char* lds; int wave, vcu, G;
    __device__ __forceinline__ int lane() const { return lane_id(); }
    __device__ __forceinline__ int tid() const { return wave * 64 + lane_id(); }
};
typedef const __attribute__((address_space(4))) Args* KA;
__device__ __forceinline__ KA kargs() { KA p = (KA)__builtin_amdgcn_kernarg_segment_ptr(); asm volatile("" : "+s"(p)); return p; }

template <class RowFn>
__device__ __forceinline__ void p0_transpose_item(const float* W, int N, const float* gk, int item, LAS float* scr, int lane, RowFn rowfn, unsigned char* w8 = nullptr, int n8lo = 0, float s8 = 1.f, bool all8 = false) {
    const int nblk = N / 32, kb = item / nblk, nb = item % nblk, k0 = 64 * kb, n0 = 32 * nb;
    f32x4 ld[8];
#pragma unroll
    for (int i = 0; i < 8; ++i) ld[i] = *(const f32x4*)(W + (size_t)(k0 + 8 * i + (lane >> 3)) * N + n0 + 4 * (lane & 7));
#pragma unroll
    for (int i = 0; i < 8; ++i) { const int kk = 8 * i + (lane >> 3); f32x4 v = ld[i]; if (gk) v = v * gk[k0 + kk];
        LAS float* d = scr + kk * 33 + 4 * (lane & 7); d[0] = v.x; d[1] = v.y; d[2] = v.z; d[3] = v.w; }
    LDS_WAIT(); asm volatile("" ::: "memory");
    const int c = lane & 7;
#pragma unroll
    for (int j = 0; j < 4; ++j) { const int n = (lane >> 3) + 8 * j; const LAS float* s = scr + (8 * c) * 33 + n;
        if (all8) { v2u o8; o8.x = pk4_fp8(s[0 * 33] * s8, s[1 * 33] * s8, s[2 * 33] * s8, s[3 * 33] * s8); o8.y = pk4_fp8(s[4 * 33] * s8, s[5 * 33] * s8, s[6 * 33] * s8, s[7 * 33] * s8);
            *(v2u*)((unsigned char*)rowfn(n0 + n) + k0 + 8 * c) = o8; continue; }
        if (w8 && n0 + n >= n8lo) { v2u o8; o8.x = pk4_fp8(s[0 * 33] * s8, s[1 * 33] * s8, s[2 * 33] * s8, s[3 * 33] * s8); o8.y = pk4_fp8(s[4 * 33] * s8, s[5 * 33] * s8, s[6 * 33] * s8, s[7 * 33] * s8);
            *(v2u*)((unsigned char*)rowfn(n0 + n) + k0 + 8 * c) = o8; continue; }
        v4u o; o.x = cvt_pk_bf16(s[0 * 33], s[1 * 33]); o.y = cvt_pk_bf16(s[2 * 33], s[3 * 33]); o.z = cvt_pk_bf16(s[4 * 33], s[5 * 33]); o.w = cvt_pk_bf16(s[6 * 33], s[7 * 33]);
        bf16* rp = rowfn(n0 + n); if (rp) *(v4u*)(rp + k0 + 8 * c) = o; }
    LDS_WAIT(); asm volatile("" ::: "memory");
}

template <class RowFn>
__device__ __forceinline__ void p0_transpose_item64(const float* W, int N, const float* gk, int item, LAS float* scr, int lane, RowFn rowfn, float s8, bool all8) {
    const int nblk = N / 64, kb = item / nblk, nb = item % nblk, k0 = 64 * kb, n0 = 64 * nb;
    f32x4 ld[16];
#pragma unroll
    for (int i = 0; i < 16; ++i) ld[i] = *(const f32x4*)(W + (size_t)(k0 + 4 * i + (lane >> 4)) * N + n0 + 4 * (lane & 15));
#pragma unroll
    for (int i = 0; i < 16; ++i) { const int kk = 4 * i + (lane >> 4), nn = 4 * (lane & 15); f32x4 v = ld[i]; if (gk) v = v * gk[k0 + kk];
        LAS float* d = scr + kk * 64; d[(nn + kk) & 63] = v.x; d[(nn + 1 + kk) & 63] = v.y; d[(nn + 2 + kk) & 63] = v.z; d[(nn + 3 + kk) & 63] = v.w; }
    LDS_WAIT(); asm volatile("" ::: "memory");
    const int c = lane & 7;
#pragma unroll
    for (int j = 0; j < 8; ++j) { const int n = (lane >> 3) + 8 * j; float e[8];
#pragma unroll
        for (int i = 0; i < 8; ++i) { const int kk = 8 * c + i; e[i] = scr[kk * 64 + ((n + kk) & 63)]; }
        if (all8) { v2u o8; o8.x = pk4_fp8(e[0] * s8, e[1] * s8, e[2] * s8, e[3] * s8); o8.y = pk4_fp8(e[4] * s8, e[5] * s8, e[6] * s8, e[7] * s8);
            *(v2u*)((unsigned char*)rowfn(n0 + n) + k0 + 8 * c) = o8; }
        else { v4u o; o.x = cvt_pk_bf16(e[0], e[1]); o.y = cvt_pk_bf16(e[2], e[3]); o.z = cvt_pk_bf16(e[4], e[5]); o.w = cvt_pk_bf16(e[6], e[7]); *(v4u*)(rowfn(n0 + n) + k0 + 8 * c) = o; } }
    LDS_WAIT(); asm volatile("" ::: "memory");
}
__device__ __forceinline__ void rms_row_to_bf16(const float* xrow, const float* gain, bf16* orow, int lane, unsigned char* f8row = nullptr) {
    const f32x4* xr = (const f32x4*)xrow + lane; const f32x4* gr = (const f32x4*)gain + lane;
    f32x4 v[4]; float s = 0.f;
#pragma unroll
    for (int j = 0; j < 4; ++j) { v[j] = xr[64 * j]; s += (v[j].x * v[j].x + v[j].y * v[j].y) + (v[j].z * v[j].z + v[j].w * v[j].w); }
    const float rs = rsqrtf(wave_sum(s) * (1.f / 1024.f) + EPS);
    unsigned long long* o8 = (unsigned long long*)orow + lane;
#pragma unroll
    for (int j = 0; j < 4; ++j) { const f32x4 g = gr[64 * j]; const float a = v[j].x * rs * g.x, b = v[j].y * rs * g.y, c = v[j].z * rs * g.z, d = v[j].w * rs * g.w;
        o8[64 * j] = (unsigned long long)cvt_pk_bf16(a, b) | ((unsigned long long)cvt_pk_bf16(c, d) << 32);
        if (f8row) ((unsigned*)f8row)[lane + 64 * j] = pk4_fp8(a, b, c, d); }
}

__device__ __forceinline__ void rms_row2_to_bf16(const float* xa, const float* xb, const float* gain, bf16* oa, bf16* ob, unsigned char* f8a, unsigned char* f8b, int lane) {
    const f32x4* ra = (const f32x4*)xa + lane; const f32x4* rb = (const f32x4*)xb + lane; const f32x4* gr = (const f32x4*)gain + lane;
    f32x4 va[4], vb[4]; float sa = 0.f, sb = 0.f;
#pragma unroll
    for (int j = 0; j < 4; ++j) { va[j] = ra[64 * j]; vb[j] = rb[64 * j]; }
#pragma unroll
    for (int j = 0; j < 4; ++j) { sa += (va[j].x * va[j].x + va[j].y * va[j].y) + (va[j].z * va[j].z + va[j].w * va[j].w); sb += (vb[j].x * vb[j].x + vb[j].y * vb[j].y) + (vb[j].z * vb[j].z + vb[j].w * vb[j].w); }
    const float rsa = rsqrtf(wave_sum(sa) * (1.f / 1024.f) + EPS), rsb = rsqrtf(wave_sum(sb) * (1.f / 1024.f) + EPS);
    unsigned long long* pa = (unsigned long long*)oa + lane; unsigned long long* pb = (unsigned long long*)ob + lane;
#pragma unroll
    for (int j = 0; j < 4; ++j) { const f32x4 g = gr[64 * j]; const f32x4 ya = va[j] * rsa * g, yb = vb[j] * rsb * g;
        pa[64 * j] = (unsigned long long)cvt_pk_bf16(ya.x, ya.y) | ((unsigned long long)cvt_pk_bf16(ya.z, ya.w) << 32);
        pb[64 * j] = (unsigned long long)cvt_pk_bf16(yb.x, yb.y) | ((unsigned long long)cvt_pk_bf16(yb.z, yb.w) << 32);
        ((unsigned*)f8a)[lane + 64 * j] = pk4_fp8(ya.x, ya.y, ya.z, ya.w); ((unsigned*)f8b)[lane + 64 * j] = pk4_fp8(yb.x, yb.y, yb.z, yb.w); }
}

__device__ __forceinline__ void p0_prologue(const Frame& F) {
    const KA ka = kargs(); unsigned char* ws = ka->ws;
    const float* x = (const float*)ka->in[0]; const float* mem = (const float*)ka->in[1]; const int* pos = (const int*)ka->in[2];
    const float* g_mix = (const float*)ka->in[3]; const float* w_in = (const float*)ka->in[4];
    const float* lru_wa = (const float*)ka->in[7]; const float* lru_wx = (const float*)ka->in[9];
    const float* g_q = (const float*)ka->in[12]; const float* w_uq = (const float*)ka->in[13]; const float* g_kv = (const float*)ka->in[14]; const float* w_ukv = (const float*)ka->in[15];
    const float* g_mem = (const float*)ka->in[16]; const float* w_mem_kv = (const float*)ka->in[17]; const float* w_branch = (const float*)ka->in[18]; const float* w_o = (const float*)ka->in[19];
    const float* g_ffn = (const float*)ka->in[20]; const float* w_group = (const float*)ka->in[21]; const float* w_router = (const float*)ka->in[23];
    const float* w_e_gate = (const float*)ka->in[25]; const float* w_e_up = (const float*)ka->in[26]; const float* w_e_down = (const float*)ka->in[27];
    bf16* WIN = (bf16*)(ws + WS_WIN); bf16* WUQ = (bf16*)(ws + WS_WUQ); bf16* WK = (bf16*)(ws + WS_WK); bf16* WV = (bf16*)(ws + WS_WV);
    bf16* WMK = (bf16*)(ws + WS_WMK); bf16* WMV = (bf16*)(ws + WS_WMV); bf16* WBR = (bf16*)(ws + WS_WBR); bf16* WO = (bf16*)(ws + WS_WO);
    bf16* WR = (bf16*)(ws + WS_WR); bf16* WLRU = (bf16*)(ws + WS_WLRU); bf16* W1 = (bf16*)(ws + WS_W1); bf16* W2 = (bf16*)(ws + WS_W2);
    LAS float* scr = (LAS float*)(F.lds + F.wave * 16384);
    const int lane = F.lane();
    const int gw = F.vcu * NWAVES + F.wave, NGW = F.G * NWAVES;
    constexpr int I_IN = 16 * 157, I_UQ = 4 * 24, I_UKV = 2 * 32, I_MKV = 16 * 32, I_BR = 3 * 8 * 32, I_O = 16 * 32, I_EG = 16 * 4, I_ED = 4 * 16, I_EXP = 2 * I_EG + I_ED;
    constexpr int NITEMS = I_IN + I_UQ + I_UKV + I_MKV + I_BR + I_O + NEXP * I_EXP;
    for (int it = gw; it < NITEMS; it += NGW) {
        int r = it;
        if (r < I_IN) { p0_transpose_item(w_in, 5024, nullptr, r, scr, lane, [&](int n) -> bf16* {
                int d; if (n < 1408) d = n; else if (n < 1440) { const int j = n - 1408; d = 1408 + 2 * (j & 15) + (j >> 4); } else d = n + 96;
                return d < 1024 ? WIN + (size_t)d * 1024 : (bf16*)(ws + WS_WG8 + (size_t)(d - 1024) * 1024); }, ws + WS_WG8, 1024, WG8_SCALE); continue; } r -= I_IN;
        if (r < I_UQ) { p0_transpose_item(w_uq, 768, g_q, r, scr, lane, [&](int n) -> bf16* {
                const int h = n / 96, d = n % 96; int dd = d; if (d >= 64) { const int j = d - 64; dd = 64 + 2 * (j & 15) + (j >> 4); }
                return (bf16*)((unsigned char*)WUQ + (size_t)(h * 96 + dd) * 256); }, nullptr, 0, WU8_SCALE, true); continue; } r -= I_UQ;
        if (r < I_UKV) { p0_transpose_item(w_ukv, 1024, g_kv, r, scr, lane, [&](int n) -> bf16* {
                const int h = n >> 7, dd = n & 127; return (bf16*)(dd < 64 ? (unsigned char*)WK + (size_t)(h * 64 + dd) * 256 : (unsigned char*)WV + (size_t)(h * 64 + dd - 64) * 256); }, nullptr, 0, WU8_SCALE, true); continue; } r -= I_UKV;
        if (r < I_MKV) { p0_transpose_item(w_mem_kv, 1024, nullptr, r, scr, lane, [&](int n) -> bf16* {
                return n < 512 ? WMK + (size_t)n * 1024 : WMV + (size_t)(n - 512) * 1024; }); continue; } r -= I_MKV;
        if (r < I_BR) { const int b = r / (8 * 32), rr = r % (8 * 32); p0_transpose_item(w_branch + (size_t)b * 512 * 1024, 1024, nullptr, rr, scr, lane, [&](int n) -> bf16* {
                return WBR + ((size_t)b * 1024 + n) * 512; }, nullptr, 0, b ? WB8_SCALE : 1.f, b != 0); continue; } r -= I_BR;
        if (r < I_O) { p0_transpose_item(w_o, 1024, nullptr, r, scr, lane, [&](int n) -> bf16* { return WO + (size_t)n * 1024; }); continue; } r -= I_O;
        { const int e = r / I_EXP; int q = r % I_EXP;
          unsigned char* const W18 = (unsigned char*)W1;
          if (q < I_EG) { p0_transpose_item64(w_e_gate + (size_t)e * 1024 * 256, 256, g_ffn, q, scr, lane, [&](int n) -> bf16* {
                  return (bf16*)(W18 + ((size_t)e * 512 + (n >> 7) * 256 + (n & 127)) * 1024); }, W18_SCALE, true); continue; } q -= I_EG;
          if (q < I_EG) { p0_transpose_item64(w_e_up + (size_t)e * 1024 * 256, 256, g_ffn, q, scr, lane, [&](int n) -> bf16* {
                  return (bf16*)(W18 + ((size_t)e * 512 + (n >> 7) * 256 + 128 + (n & 127)) * 1024); }, W18_SCALE, true); continue; } q -= I_EG;
          p0_transpose_item64(w_e_down + (size_t)e * 256 * 1024, 1024, nullptr, q, scr, lane, [&](int n) -> bf16* { return (bf16*)((unsigned char*)W2 + ((size_t)e * 1024 + n) * 256); }, W28_SCALE, true); }
    }
    const int gt = F.vcu * (NWAVES * 64) + F.wave * 64 + lane, NGT = F.G * NWAVES * 64;
    for (int i = gt; i < 96 * 1024 / 16; i += NGT) *(v4u*)(ws + WS_WG8 + (size_t)(1440 - 1024) * 1024 + (size_t)i * 16) = (v4u){0u, 0u, 0u, 0u};
    for (int i = gt; i < 2 * 512 * 8; i += NGT) { const int mat = i >> 12, r = (i >> 3) & 511, ch = i & 7; *(v4u*)((unsigned char*)(mat ? WV : WK) + (size_t)r * 256 + 128 + ch * 16) = (v4u){0u, 0u, 0u, 0u}; }
    for (int i = gt; i < 256 * 1024; i += NGT) { const int r = i >> 10, k = i & 1023; float v = 0.f;
        if (r < 32) v = w_router[k * 32 + r] * g_ffn[k]; else if (r >= 128 && r < 132) v = w_group[k * 4 + (r - 128)] * g_ffn[k];
        WR[i] = f2bf(v); }
    for (int i = gt; i < 2 * 8 * 64 * 64; i += NGT) { const int mat = i >> 15, n = (i >> 12) & 7, d = (i >> 6) & 63, c = i & 63;
        const float* src = mat ? lru_wx : lru_wa; WLRU[i] = f2bf(src[(n * 64 + c) * 64 + d]); }
    { float* cosT = (float*)(ws + WS_COS); float* sinT = (float*)(ws + WS_SIN);
      for (int i = gt; i < T * 16; i += NGT) { const int t = i >> 4, f = i & 15;
          const double c4[4] = {1.0, 0.5623413251903491, 0.31622776601683794, 0.1778279410038923};
          double inv = (f & 3) == 0 ? c4[0] : ((f & 3) == 1 ? c4[1] : ((f & 3) == 2 ? c4[2] : c4[3]));
          const int dec = f >> 2; inv *= dec == 0 ? 1.0 : (dec == 1 ? 0.1 : (dec == 2 ? 0.01 : 0.001));
          const double rev = (double)pos[t] * inv * 0.15915494309189535; const float fr = (float)(rev - __builtin_rint(rev));
          cosT[i] = __builtin_amdgcn_cosf(fr); sinT[i] = __builtin_amdgcn_sinf(fr); } }
    bf16* XN = (bf16*)(ws + WS_XN); bf16* MEMN = (bf16*)(ws + WS_MEMN);
    unsigned char* XN8 = (unsigned char*)ka->out + DO_XN8;
    if (T % (2 * NGW) != 0) { for (int m = gw; m < T; m += NGW) rms_row_to_bf16(x + (size_t)m * DM, g_mix, XN + (size_t)m * DM, lane, XN8 + (size_t)m * DM); }
    else for (int m = gw; m < T; m += 2 * NGW) rms_row2_to_bf16(x + (size_t)m * DM, x + (size_t)(m + NGW) * DM, g_mix, XN + (size_t)m * DM, XN + (size_t)(m + NGW) * DM, XN8 + (size_t)m * DM, XN8 + (size_t)(m + NGW) * DM, lane);
    for (int m = gw; m < MROWS; m += NGW) rms_row_to_bf16(mem + (size_t)m * DM, g_mem, MEMN + (size_t)m * DM, lane);
}

template <int PASS>
__device__ __forceinline__ void lru_unit(const Frame& F, int b, int seg) {
    const KA ka = kargs(); unsigned char* ws = ka->ws;
    const float* conv_w = (const float*)ka->in[5]; const float* conv_b = (const float*)ka->in[6]; const float* lru_ba = (const float*)ka->in[8]; const float* lru_bx = (const float*)ka->in[10];
    const float* lam = (const float*)ka->in[11];
    const bf16* XL = (const bf16*)(ws + WS_XL); bf16* GL = (bf16*)(ws + WS_GL); const bf16* WLRU = (const bf16*)(ws + WS_WLRU); float* LSUM = (float*)(ws + WS_LSUM);
    constexpr int XAST = 1040, GST = 2064, XA_OFF = 0, GA_OFF = 16 * XAST, GX_OFF = GA_OFF + 16 * GST;
    const int n = F.wave, lane = lane_id(), c = n * 64 + lane, fr = lane & 15, fq = lane >> 4;
    const float cw0 = conv_w[c], cw1 = conv_w[512 + c], cw2 = conv_w[1024 + c], cw3 = conv_w[1536 + c], cb = conv_b[c], ba = lru_ba[c], bx = lru_bx[c];
    const float sp8 = -8.0f * log1pf(expf(-lam[c]));
    bf16x8 waf[4][2], wxf[4][2];
#pragma unroll
    for (int nt = 0; nt < 4; ++nt)
#pragma unroll
        for (int ks = 0; ks < 2; ++ks) { const size_t o = (size_t)(n * 64 + 16 * nt + fr) * 64 + 32 * ks + 8 * fq;
            waf[nt][ks] = *(const bf16x8*)(WLRU + o); wxf[nt][ks] = *(const bf16x8*)(WLRU + 32768 + o); }
    const size_t t0 = (size_t)b * SEQ + (size_t)seg * 128;
    float xm1 = 0.f, xm2 = 0.f, xm3 = 0.f;
    if (seg > 0) { xm1 = bf2f(XL[(t0 - 1) * 512 + c]); xm2 = bf2f(XL[(t0 - 2) * 512 + c]); xm3 = bf2f(XL[(t0 - 3) * 512 + c]); }
    float h = 0.f, ap = 1.f;
    if (PASS == 2) { const float* sb = LSUM + (size_t)b * 32 * 1024;
        for (int s = 0; s < seg; ++s) h = sb[s * 1024 + c] * h + sb[s * 1024 + 512 + c]; }
    LAS unsigned char* lds = F.lds;
    bf16 xr[16], gr[16];
#pragma unroll
    for (int tt = 0; tt < 16; ++tt) { xr[tt] = XL[(t0 + tt) * 512 + c]; gr[tt] = PASS == 2 ? GL[(t0 + tt) * 512 + c] : (bf16)0; }
    for (int sub = 0; sub < 8; ++sub) {
        const size_t ts = t0 + sub * 16;
        float xav[16], glv[16];
#pragma unroll
        for (int tt = 0; tt < 16; ++tt) { const float x0 = bf2f(xr[tt]);
            if (PASS == 2) glv[tt] = bf2f(gr[tt]);
            const float xa = cw3 * x0 + cw2 * xm1 + cw1 * xm2 + cw0 * xm3 + cb; xm3 = xm2; xm2 = xm1; xm1 = x0; xav[tt] = xa;
            *(LAS bf16*)(lds + XA_OFF + tt * XAST + c * 2) = f2bf(xa); }
        if (sub < 7) {
#pragma unroll
            for (int tt = 0; tt < 16; ++tt) { xr[tt] = XL[(ts + 16 + tt) * 512 + c]; if (PASS == 2) gr[tt] = GL[(ts + 16 + tt) * 512 + c]; }
        }
        { f32x4 aa[4], ax[4];
#pragma unroll
          for (int nt = 0; nt < 4; ++nt) { aa[nt] = (f32x4){0.f, 0.f, 0.f, 0.f}; ax[nt] = (f32x4){0.f, 0.f, 0.f, 0.f}; }
#pragma unroll
          for (int ks = 0; ks < 2; ++ks) { const bf16x8 xf = *(const LAS bf16x8*)(lds + XA_OFF + fr * XAST + (n * 64 + 32 * ks + 8 * fq) * 2);
#pragma unroll
              for (int nt = 0; nt < 4; ++nt) { aa[nt] = __builtin_amdgcn_mfma_f32_16x16x32_bf16(waf[nt][ks], xf, aa[nt], 0, 0, 0); ax[nt] = __builtin_amdgcn_mfma_f32_16x16x32_bf16(wxf[nt][ks], xf, ax[nt], 0, 0, 0); } }
#pragma unroll
          for (int nt = 0; nt < 4; ++nt) { *(LAS f32x4*)(lds + GA_OFF + fr * GST + (n * 64 + 16 * nt + 4 * fq) * 4) = aa[nt]; *(LAS f32x4*)(lds + GX_OFF + fr * GST + (n * 64 + 16 * nt + 4 * fq) * 4) = ax[nt]; } }
#pragma unroll
        for (int tt = 0; tt < 16; ++tt) {
            const float ga = *(const LAS float*)(lds + GA_OFF + tt * GST + c * 4) + ba, gx = *(const LAS float*)(lds + GX_OFF + tt * GST + c * 4) + bx;
            const float r = fast_sigmoid(ga), ig = fast_sigmoid(gx);
            const float la = sp8 * r, av = __builtin_amdgcn_exp2f(la * LOG2E);
            const float mult = __builtin_sqrtf(fmaxf(1.0f - av * av, 0.f));
            h = av * h + mult * ig * xav[tt];
            if (PASS == 1) ap *= av;
            if (PASS == 2) GL[(ts + tt) * 512 + c] = f2bf(h * glv[tt]);
        }
    }
    if (PASS == 1) { float* sb = LSUM + ((size_t)b * 32 + seg) * 1024; sb[c] = ap; sb[512 + c] = h; }
    __syncthreads();
}

__device__ __forceinline__ MoeTab moe_tables(const Frame& F, const unsigned* gcnt) {
    LAS int* p = (LAS int*)(F.lds + MOE_OFF);
    const int tid = F.tid();
    __syncthreads();
    if (tid < 32) p[tid] = (int)gcnt[tid];
    __syncthreads();
    if (tid == 0) { int base = 0, nt = 0;
        for (int e = 0; e < 32; ++e) { const int c = p[e], ntl = (c + 255) >> 8; p[32 + e] = base;
            for (int r = 0; r < ntl; ++r) { p[128 + nt] = e; p[128 + MAXTILES + nt] = r; ++nt; }
            base += ntl * 256; }
        p[64] = nt; }
    __syncthreads();
    MoeTab t; t.p = p; return t;
}

constexpr int NPHASE = 10;
__global__ void __launch_bounds__(NWAVES * 64, 2) fwd_kernel(Args args) {
    extern __shared__ __attribute__((aligned(16))) unsigned char lds_raw[];
    Frame F;
    F.lds = (LAS unsigned char*)lds_raw;
    F.wave = __builtin_amdgcn_readfirstlane((int)threadIdx.x >> 6);
    F.G = gridDim.x; { const int bx = blockIdx.x; F.vcu = (F.G % 8 == 0) ? (bx % 8) * (F.G / 8) + bx / 8 : bx; }
    const KA ka0 = kargs();
    unsigned* ctl0 = (unsigned*)(ka0->ws + WS_CTL);
    volatile LAS unsigned* MISC = (volatile LAS unsigned*)(F.lds + MISC_OFF);
    { const int t0_ = F.tid(); if (t0_ < 32) MISC[t0_] = 0u; }
    __syncthreads();
    XcdBarrier bar; bar.bar = ctl0 + CW_BAR; bar.x = 0; bar.st = nullptr; bar.wave = F.wave;
    if (!MK_SPLIT) bar = xcd_barrier_post(ctl0 + CW_BAR, MISC + 8, F.wave);
    const int lo = ka0->ph_lo, hi = ka0->ph_hi;
#ifndef PH_MASK
#define PH_MASK 0x3ff
#endif
#define IN(k) (((PH_MASK >> (k)) & 1) && lo <= (k) && (k) < hi)
#define GRID_BAR(k) do { if (!MK_SPLIT && IN((k) + 1)) xcd_barrier(bar); } while (0)

#define PHASE_PTRS const KA ka = kargs(); unsigned char* const ws = ka->ws; unsigned* const ctl = (unsigned*)(ws + WS_CTL); \
    float* const ssq_q = (float*)(ws + WS_SSQQ); float* const ssq_kv = (float*)(ws + WS_SSQKV); float* const ssq_h = (float*)(ws + WS_SSQH); unsigned* const gcnt = ctl + CW_CNT; \
    const float* const cosT = (const float*)(ws + WS_COS); const float* const sinT = (const float*)(ws + WS_SIN); unsigned char* const dob = (unsigned char*)ka->out; \
    bf16* const Qb = (bf16*)(dob + DO_Q); bf16* const Kb = (bf16*)(dob + DO_K); bf16* const Vtb = (bf16*)(dob + DO_VT); \
    (void)ssq_q; (void)ssq_kv; (void)ssq_h; (void)gcnt; (void)cosT; (void)sinT; (void)Qb; (void)Kb; (void)Vtb;

    if (IN(0)) { _Pragma("unroll") for (int rep = 0; rep < REPN(0); ++rep) p0_prologue(F); GRID_BAR(0); }

    if (IN(1)) { PHASE_PTRS
        _Pragma("unroll") for (int rep = 0; rep < REPN(1); ++rep) {
        const bool PSKIP = REPN(1) == 2 && rep == 0 && (PROBE_SKIP == 1 ? (F.vcu & 1) != 0 : PROBE_SKIP == 2 ? (F.vcu >> 5) < 4 : PROBE_SKIP >= 3);
        { const SchedGrid2 S = make_grid1(F.G, F.vcu, T / 256, 4, ws + WS_XN, ws + WS_WIN, 1024, 1024);
          const EpiProj E{(bf16*)(ws + WS_XL), (bf16*)(ws + WS_GL), (bf16*)(ws + WS_CQ), (bf16*)(ws + WS_CKV), (bf16*)(ws + WS_QM), (bf16*)(ws + WS_SG), (bf16*)(dob + DO_KR), ssq_q, ssq_kv, cosT, sinT, PSKIP, 0, 1.0f};
          pg8::gemm_phase<EpiProj, SchedGrid2, true, false>(F.lds, F.wave, 1024, 1024, 1024, S, E); }
        { const SchedGrid2 S = make_grid1(F.G, F.vcu, T / 256, 16, dob + DO_XN8, ws + WS_WG8, 512, 512);
          const EpiProj E{(bf16*)(ws + WS_XL), (bf16*)(ws + WS_GL), (bf16*)(ws + WS_CQ), (bf16*)(ws + WS_CKV), (bf16*)(ws + WS_QM), (bf16*)(ws + WS_SG), (bf16*)(dob + DO_KR), ssq_q, ssq_kv, cosT, sinT, PSKIP, 4, GATE_UNSCALE};
          pg8::gemm_phase<EpiProj, SchedGrid2, true, false, true>(F.lds, F.wave, 512, 512, 512, S, E); }
        }
        GRID_BAR(1);
    }

    if (IN(2)) { PHASE_PTRS
#ifndef SUBM
#define SUBM 0xff
#endif
        _Pragma("unroll") for (int rep = 0; rep < REPN(2); ++rep) {
        const bool deal = (F.G == 256); const int ce = F.vcu < 128 ? F.vcu : F.vcu - 32, Gq = deal ? 224 : F.G;
        const int cq = !deal ? F.vcu : ((F.vcu >= 128 && F.vcu < 160) ? (1 << 20) : ce), ck = !deal ? F.vcu : ((F.vcu >= 128 && F.vcu < 160) ? (1 << 20) : 223 - ce);
        if (SUBM & 1) { const SchedGrid2 S = make_grid1(Gq, cq, T / 256, 3, ws + WS_CQ, ws + WS_WUQ, 128, 128);
          const EpiQ E{Qb, ssq_q, cosT, sinT};
          pg8::gemm_phase<EpiQ, SchedGrid2, true, false, true>(F.lds, F.wave, 128, 128, 128, S, E); }
        if (SUBM & 2) { const SchedGrid2 S = make_grid2(Gq, ck, T / 256, 2, ws + WS_CKV, ws + WS_WK, 2, T / 256, ws + WS_WV, ws + WS_CKV, 128, 128);
          const EpiKV E{Kb, Vtb, ssq_kv};
          pg8::gemm_phase<EpiKV, SchedGrid2, true, false, true>(F.lds, F.wave, 128, 128, 128, S, E); }
        if ((SUBM & 4) && !(PROBE_SKIP == 11 && REPN(2) == 2 && rep == 0)) { const SchedGrid2 S = make_grid2(F.G, (F.vcu + F.G / 2) % F.G, MROWS / 256, 2, ws + WS_MEMN, ws + WS_WMK, 2, MROWS / 256, ws + WS_WMV, ws + WS_MEMN, 1024, 1024);
          const EpiMem E{(bf16*)(ws + WS_MK), (bf16*)(ws + WS_MVT)};
          pg8::gemm_phase<EpiMem, SchedGrid2, true, false>(F.lds, F.wave, 1024, 1024, 1024, S, E); }
        __syncthreads();
        _Pragma("unroll") for (int rep2 = 0; rep2 < REPN(10); ++rep2)
        if (SUBM & 8) for (int u = F.vcu; u < NB * 32; u += F.G) lru_unit<1>(F, u >> 5, u & 31);
        }
        GRID_BAR(2);
    }

    if (IN(3)) { PHASE_PTRS
        bf16* YB = (bf16*)(ws + WS_YB);
        _Pragma("unroll") for (int rep = 0; rep < REPN(3); ++rep)
        if (SUBM & 1) for (int i = 0;; ++i) {
            int bh, qb2;
            if (F.G == 256) { if (i >= 2) break; const int cc = F.vcu & 3; bh = F.vcu >> 2; qb2 = i == 0 ? 7 - cc : cc; }
            else { const int uu = i * F.G + F.vcu; if (uu >= 512) break; bh = uu >> 3; qb2 = 7 - (uu & 7); }
            const int b = bh >> 3, h = bh & 7; const size_t r0 = (size_t)b * SEQ;
            att::unit_g<96, 64, true>(F.lds, F.wave, Qb + (r0 + 512 * qb2) * 768 + h * 96, 768, Kb + r0 * 512 + h * 64, 512, (const bf16*)(dob + DO_KR) + r0 * 32, 32, Vtb + ((size_t)b * 512 + h * 64) * 4096, 4096,
                                (bf16*)((unsigned char*)YB + (r0 + 512 * qb2) * 1024 + h * 64), 1024, 512 * qb2, 8 * (qb2 + 1));
        }
        bf16* QM = (bf16*)(ws + WS_QM); const bf16* MK = (const bf16*)(ws + WS_MK); const bf16* MVT = (const bf16*)(ws + WS_MVT);
        if (SUBM & 2) for (int uu = F.vcu; uu < NB * 4 * 16; uu += F.G) {
            const int b = uu >> 6, h = (uu >> 4) & 3, qb = uu & 15; const size_t r0 = (size_t)b * SEQ + 256 * qb;
            att::unit<128, 128, false, true>(F.lds, F.wave, QM + r0 * 512 + h * 128, 512, MK + (size_t)b * 256 * 512 + h * 128, 512, MVT + ((size_t)b * 512 + h * 128) * 256, 256,
                                       (bf16*)(ws + WS_YC8 + r0 * 1024 + h * 128), 1024, 0, 4);
        }
        if (SUBM & 4) for (int u = F.vcu; u < NB * 32; u += F.G) lru_unit<2>(F, u >> 5, u & 31);
        GRID_BAR(3);
    }

    if (IN(4)) { PHASE_PTRS
        const SchedBranch S{F.G, F.vcu, (const char*)ws};
        EpiBranch E{(const bf16*)(ws + WS_SG), (bf16*)(ws + WS_MG), {}};
#pragma unroll
        for (int k = 0; k < 16; ++k) E.hold[k] = (v2u){0u, 0u};
        _Pragma("unroll") for (int rep = 0; rep < REPN(4); ++rep)
        pg8::gemm_phase<EpiBranch, SchedBranch, true, false, false, true>(F.lds, F.wave, 512, 512, 512, S, E);
        GRID_BAR(4);
    }

    if (IN(5)) { PHASE_PTRS
        const SchedGrid2 S = make_grid1(F.G, F.vcu, T / 256, 4, ws + WS_MG, ws + WS_WO, 1024, 1024);
        _Pragma("unroll") for (int rep = 0; rep < REPN(5); ++rep) {
        const EpiWo E{(const float*)ka->in[0], ka->out, (bf16*)(ws + WS_HB), ssq_h, rep == 0, ws + WS_HB8};
        pg8::gemm_phase<EpiWo, SchedGrid2, true, false>(F.lds, F.wave, 1024, 1024, 1024, S, E); }
        GRID_BAR(5);
    }

    if (IN(6)) { PHASE_PTRS
        const SchedGrid2 S = make_grid1(F.G, F.vcu, T / 256, 1, ws + WS_HB, ws + WS_WR, 1024, 1024);
        const EpiRouter E{ssq_h, (const float*)ka->in[22], (const float*)ka->in[24], gcnt, (int*)(ws + WS_LTOK), (float*)(ws + WS_LW), (int*)(ws + WS_PICK), (float*)(ws + WS_RSH)};
        if (F.G >= T / 256) pg8::gemm_phase<EpiRouter, SchedGrid2, false, false>(F.lds, F.wave, 1024, 1024, 1024, S, E);
        GRID_BAR(6);
    }

    if (IN(7)) { PHASE_PTRS
        const MoeTab tab = moe_tables(F, gcnt);
        const SchedMoe<2, true> S{F.G, F.vcu, tab, (const char*)(ws + WS_HB8), (const char*)(ws + WS_W1), (size_t)512 * 1024, (size_t)256 * 1024, (const int*)(ws + WS_LTOK)};
        const EpiE1 E{(const float*)(ws + WS_RSH), (const int*)(ws + WS_LTOK), (bf16*)(ws + WS_HD), tab};
        _Pragma("unroll") for (int rep = 0; rep < REPN(7); ++rep)
        pg8::gemm_phase<EpiE1, SchedMoe<2, true>, true, true, true>(F.lds, F.wave, 512, 512, 512, S, E);
        GRID_BAR(7);
    }

    if (IN(8)) { PHASE_PTRS
        const MoeTab tab = moe_tables(F, gcnt);
        const SchedMoe<4, false> S{F.G, F.vcu, tab, (const char*)(ws + WS_HD), (const char*)(ws + WS_W2), (size_t)1024 * 256, (size_t)256 * 256, nullptr};
        const EpiE2 E{(const float*)(ws + WS_LW), ws + WS_YE, tab};
        _Pragma("unroll") for (int rep = 0; rep < REPN(8); ++rep)
        pg8::gemm_phase<EpiE2, SchedMoe<4, false>, true, false, true>(F.lds, F.wave, 128, 128, 128, S, E);
        GRID_BAR(8);
    }

    if (IN(9)) { PHASE_PTRS
        const MoeTab tab = moe_tables(F, gcnt);
        const int* pick = (const int*)(ws + WS_PICK); const unsigned char* YE = ws + WS_YE; const float* gfin = (const float*)ka->in[28]; float* outp = ka->out; const bf16* HBp = (const bf16*)(ws + WS_HB);
        const int gw = F.vcu * NWAVES + F.wave, NGW = F.G * NWAVES, lane = F.lane();
        const f32x4* g4 = (const f32x4*)gfin + lane;
#define P9_PICKS(M, MB, P) do { P[0] = pick[2 * (M)]; P[1] = pick[2 * (M) + 1]; P[2] = pick[2 * (MB)]; P[3] = pick[2 * (MB) + 1]; } while (0)
#define P9_LOADS(M, MB, P, WA, WB, EA, EB) do { \
            const unsigned* ya0 = (const unsigned*)(YE + (size_t)(tab.base(P[0] >> 16) + (P[0] & 0xffff)) * DM) + lane; const unsigned* ya1 = (const unsigned*)(YE + (size_t)(tab.base(P[1] >> 16) + (P[1] & 0xffff)) * DM) + lane; \
            const unsigned* yb0 = (const unsigned*)(YE + (size_t)(tab.base(P[2] >> 16) + (P[2] & 0xffff)) * DM) + lane; const unsigned* yb1 = (const unsigned*)(YE + (size_t)(tab.base(P[3] >> 16) + (P[3] & 0xffff)) * DM) + lane; \
            const v2u* ha = (const v2u*)(HBp + (size_t)(M) * DM) + lane; const v2u* hb = (const v2u*)(HBp + (size_t)(MB) * DM) + lane; \
            _Pragma("unroll") for (int j = 0; j < 4; ++j) { WA[j] = ha[64 * j]; EA[j][0] = ya0[64 * j]; EA[j][1] = ya1[64 * j]; WB[j] = hb[64 * j]; EB[j][0] = yb0[64 * j]; EB[j][1] = yb1[64 * j]; } } while (0)
        int pk[4]; v2u wa[4], wb[4]; unsigned ea[4][2], eb[4][2];
        { const int m0 = gw, mb0 = (m0 + NGW < T) ? m0 + NGW : m0; if (m0 < T) { P9_PICKS(m0, mb0, pk); P9_LOADS(m0, mb0, pk, wa, wb, ea, eb); } }
        for (int m = gw; m < T; m += 2 * NGW) {
            const int mb = (m + NGW < T) ? m + NGW : m;
            const int mn = m + 2 * NGW, mbn = (mn + NGW < T) ? mn + NGW : mn; const bool more = mn < T;
            int pn[4] = {0, 0, 0, 0}; if (more) P9_PICKS(mn, mbn, pn);
            f32x4 va[4], vb[4]; float sa = 0.f, sb = 0.f;
#pragma unroll
            for (int j = 0; j < 4; ++j) {
                const f32x2 a0l = __builtin_amdgcn_cvt_pk_f32_fp8((int)ea[j][0], false), a0h = __builtin_amdgcn_cvt_pk_f32_fp8((int)ea[j][0], true), a1l = __builtin_amdgcn_cvt_pk_f32_fp8((int)ea[j][1], false), a1h = __builtin_amdgcn_cvt_pk_f32_fp8((int)ea[j][1], true);
                const f32x2 b0l = __builtin_amdgcn_cvt_pk_f32_fp8((int)eb[j][0], false), b0h = __builtin_amdgcn_cvt_pk_f32_fp8((int)eb[j][0], true), b1l = __builtin_amdgcn_cvt_pk_f32_fp8((int)eb[j][1], false), b1h = __builtin_amdgcn_cvt_pk_f32_fp8((int)eb[j][1], true);
                va[j] = (f32x4){bf_lo(wa[j].x) + a0l[0] + a1l[0], bf_hi(wa[j].x) + a0l[1] + a1l[1], bf_lo(wa[j].y) + a0h[0] + a1h[0], bf_hi(wa[j].y) + a0h[1] + a1h[1]};
                vb[j] = (f32x4){bf_lo(wb[j].x) + b0l[0] + b1l[0], bf_hi(wb[j].x) + b0l[1] + b1l[1], bf_lo(wb[j].y) + b0h[0] + b1h[0], bf_hi(wb[j].y) + b0h[1] + b1h[1]};
                sa += (va[j].x * va[j].x + va[j].y * va[j].y) + (va[j].z * va[j].z + va[j].w * va[j].w); sb += (vb[j].x * vb[j].x + vb[j].y * vb[j].y) + (vb[j].z * vb[j].z + vb[j].w * vb[j].w); }
            if (more) P9_LOADS(mn, mbn, pn, wa, wb, ea, eb);
            const float rsa = rsqrtf(wave_sum(sa) * (1.f / 1024.f) + EPS), rsb = rsqrtf(wave_sum(sb) * (1.f / 1024.f) + EPS);
            f32x4* oa = (f32x4*)(outp + (size_t)m * DM) + lane; f32x4* ob = (f32x4*)(outp + (size_t)mb * DM) + lane;
#pragma unroll
            for (int j = 0; j < 4; ++j) { const f32x4 g = g4[64 * j]; oa[64 * j] = va[j] * rsa * g; ob[64 * j] = vb[j] * rsb * g; }
        }
#undef P9_PICKS
#undef P9_LOADS
    }
#undef IN
#undef GRID_BAR
}

extern "C" void kernel_launch(void* const* d_in, const int* in_sizes, int n_in, void* d_out, int out_size, void* d_ws, size_t ws_size, hipStream_t stream) {
    static int grid = 0;
    if (grid == 0) {
        if (n_in != 29 || in_sizes[0] != T * DM || out_size != T * DM || ws_size < WS_END) {
            fprintf(stderr, "kernel_launch: unexpected shapes (n_in %d, in0 %d, out %d, ws %zu < %zu); nothing launched\n", n_in, n_in > 0 ? in_sizes[0] : -1, out_size, ws_size, (size_t)WS_END); grid = -1; return; }
        int dev = 0, cus = 0, per_cu = 0;
        if (hipGetDevice(&dev) != hipSuccess || hipDeviceGetAttribute(&cus, hipDeviceAttributeMultiprocessorCount, dev) != hipSuccess) { grid = -1; return; }
        if (hipFuncSetAttribute((const void*)fwd_kernel, hipFuncAttributeMaxDynamicSharedMemorySize, LDS_BYTES) != hipSuccess) { fprintf(stderr, "kernel_launch: hipFuncSetAttribute failed\n"); grid = -1; return; }
        if (hipOccupancyMaxActiveBlocksPerMultiprocessor(&per_cu, (const void*)fwd_kernel, NWAVES * 64, LDS_BYTES) != hipSuccess || per_cu < 1)
            fprintf(stderr, "kernel_launch: note: occupancy query reports %d workgroups per CU\n", per_cu);
        (void)hipGetLastError();
        grid = cus;
    }
    if (grid < 0) return;
    if (hipMemsetAsync((char*)d_ws + WS_CTL, 0, CTL_ZERO_BYTES, stream) != hipSuccess) return;
    Args a{};
    for (int i = 0; i < 29; ++i) a.in[i] = d_in[i];
    a.out = (float*)d_out; a.ws = (unsigned char*)d_ws;
#if MK_SPLIT
    for (int p = 0; p < NPHASE; ++p) { a.ph_lo = p; a.ph_hi = p + 1; hipLaunchKernelGGL(fwd_kernel, dim3(grid), dim3(NWAVES * 64), LDS_BYTES, stream, a); }
#else
    a.ph_lo = 0; a.ph_hi = NPHASE;
    hipLaunchKernelGGL(fwd_kernel, dim3(grid), dim3(NWAVES * 64), LDS_BYTES, stream, a);
#endif
    const hipError_t le = hipPeekAtLastError();
    if (le != hipSuccess) fprintf(stderr, "kernel_launch: launch failed: %s\n", hipGetErrorName(le));
}
```

```cpp
#include <hip/hip_runtime.h>
#include <cstdio>
#include <cstdint>

#define GAS __attribute__((address_space(1)))
#define LAS __attribute__((address_space(3)))
typedef unsigned short bf16;
typedef unsigned v4u __attribute__((ext_vector_type(4)));
typedef unsigned v2u __attribute__((ext_vector_type(2)));
typedef float f32x4 __attribute__((ext_vector_type(4)));
typedef float f32x2 __attribute__((ext_vector_type(2)));
typedef float f32x16 __attribute__((ext_vector_type(16)));
typedef short bf16x8 __attribute__((ext_vector_type(8)));
typedef int i32x4 __attribute__((ext_vector_type(4)));
typedef int i32x8 __attribute__((ext_vector_type(8)));
#define RLX_AGENT __ATOMIC_RELAXED, __HIP_MEMORY_SCOPE_AGENT
#define LDS_WAIT() asm volatile("s_waitcnt lgkmcnt(0)" ::: "memory")
#define VM_WAIT() asm volatile("s_waitcnt vmcnt(0)" ::: "memory")

#ifndef DBG_BR
#define DBG_BR 7
#endif
#ifndef DBG_OUT
#define DBG_OUT 0
#endif
#ifndef PROBE_REP
#define PROBE_REP 0
#endif
#define REPN(k) ((((PROBE_REP) >> (k)) & 1) ? 2 : 1)
#ifndef PROBE_SKIP
#define PROBE_SKIP 0
#endif
#ifndef MK_SPLIT
#define MK_SPLIT 0
#endif

constexpr int NB = 8, SEQ = 4096, T = NB * SEQ, DM = 1024, MEMLEN = 256, MROWS = NB * MEMLEN;
constexpr int NPROJ = 5120;
constexpr int NEXP = 32, DEXP = 256;
constexpr float EPS = 1e-6f;
constexpr float LOG2E = 1.4426950408889634f;
constexpr float C2_MLA = 0.10206207261596575f * LOG2E;
constexpr float C2_MEM = 0.08838834764831845f * LOG2E;
constexpr int NWAVES = 8;
constexpr int MAXTILES = 288;

constexpr size_t MiB = 1u << 20;
constexpr size_t WS_CTL = 0, CTL_ZERO_BYTES = 1 * MiB;
constexpr size_t WS_WIN = 1 * MiB;
constexpr size_t WS_WG8 = 5 * MiB;
constexpr size_t WS_WUQ = 11 * MiB;
constexpr size_t WS_WK = 11 * MiB + 512 * 1024;
constexpr size_t WS_WV = 11 * MiB + 768 * 1024;
constexpr size_t WS_WMK = 12 * MiB;
constexpr size_t WS_WMV = 13 * MiB;
constexpr size_t WS_WBR = 14 * MiB;
constexpr size_t WS_WO = 17 * MiB;
constexpr size_t WS_WR = 19 * MiB;
constexpr size_t WS_WLRU = 19 * MiB + 512 * 1024;
constexpr size_t WS_COS = 20 * MiB, WS_SIN = 22 * MiB;
constexpr size_t WS_W1 = 24 * MiB;
constexpr size_t WS_W2 = 56 * MiB;
constexpr size_t WS_LSUM = 72 * MiB;
constexpr size_t WS_LTOK = 73 * MiB;
constexpr size_t WS_LW = 77 * MiB;
constexpr size_t WS_PICK = 81 * MiB;
constexpr size_t WS_XN = 84 * MiB;
constexpr size_t WS_MG = WS_XN;
constexpr size_t WS_MEMN = 148 * MiB;
constexpr size_t WS_MK = 152 * MiB;
constexpr size_t WS_MVT = 154 * MiB;
constexpr size_t WS_XL = 156 * MiB;
constexpr size_t WS_GL = 188 * MiB;
constexpr size_t WS_HB = 156 * MiB;
constexpr size_t WS_CQ = 220 * MiB;
constexpr size_t WS_CKV = 236 * MiB;
constexpr size_t WS_HB8 = 220 * MiB;
constexpr size_t WS_YB = 220 * MiB;
constexpr size_t WS_QM = 252 * MiB;
constexpr size_t WS_SG = 284 * MiB;
constexpr size_t WS_HD = 284 * MiB;
constexpr size_t WS_YE = 320 * MiB;
constexpr size_t WS_YC8 = 384 * MiB;
constexpr size_t WS_SSQQ = 476 * MiB;
constexpr size_t WS_SSQKV = 476 * MiB + 512 * 1024;
constexpr size_t WS_SSQH = 477 * MiB;
constexpr size_t WS_RSH = 479 * MiB;
constexpr size_t WS_END = 480 * MiB;
constexpr size_t DO_Q = 0, DO_K = 48 * MiB, DO_KR = 80 * MiB, DO_VT = 96 * MiB;
constexpr size_t DO_XN8 = 0;
constexpr float WG8_SCALE = 64.0f, W18_SCALE = 64.0f;
constexpr float WU8_SCALE = 64.0f, CL8_SCALE = 8.0f;
constexpr float W28_SCALE = 64.0f, HD8_SCALE = 8.0f;
constexpr float WB8_SCALE = 64.0f, Y8_SCALE = 32.0f;
#ifndef GATE_UNSCALE
#define GATE_UNSCALE (1.0f / WG8_SCALE)
#endif
constexpr int CW_TMO = 0;
constexpr int CW_BAR = 4096;
constexpr int CW_CNT = 8192;
constexpr int CW_SSQQ = 65536, CW_SSQKV = 65536 + 32768, CW_SSQH = 65536 + 65536;

constexpr int RING_BYTES = 131072;
constexpr int MOE_OFF = RING_BYTES;
constexpr int MISC_OFF = RING_BYTES + 4096;
constexpr int LDS_BYTES = 147456;

__device__ __forceinline__ int lane_id() { unsigned m = ~0u; asm volatile("" : "+s"(m)); return (int)__builtin_amdgcn_mbcnt_hi(m, __builtin_amdgcn_mbcnt_lo(m, 0u)); }
typedef __bf16 bf16x2_t __attribute__((ext_vector_type(2)));
__device__ __forceinline__ unsigned cvt_pk_bf16(float lo, float hi) { f32x2 v = {lo, hi}; bf16x2_t b = __builtin_convertvector(v, bf16x2_t); return __builtin_bit_cast(unsigned, b); }
__device__ __forceinline__ unsigned pk4_fp8(float a, float b, float c, float d) { int w = 0; w = __builtin_amdgcn_cvt_pk_fp8_f32(a, b, w, false); w = __builtin_amdgcn_cvt_pk_fp8_f32(c, d, w, true); return (unsigned)w; }
__device__ __forceinline__ float sat8(float v) { return __builtin_fminf(__builtin_fmaxf(v, -448.0f), 448.0f); }
__device__ __forceinline__ float bf_lo(unsigned w) { return __uint_as_float(w << 16); }
__device__ __forceinline__ float bf_hi(unsigned w) { return __uint_as_float(w & 0xffff0000u); }
__device__ __forceinline__ float bf2f(bf16 b) { return __uint_as_float((unsigned)b << 16); }
__device__ __forceinline__ bf16 f2bf(float f) { return (bf16)(cvt_pk_bf16(f, 0.f) & 0xffffu); }
__device__ __forceinline__ float fast_sigmoid(float x) { return __builtin_amdgcn_rcpf(1.0f + __builtin_amdgcn_exp2f(-x * LOG2E)); }
__device__ __forceinline__ float gelu_tanh(float x) { const float u = 0.7978845608028654f * (x + 0.044715f * x * x * x); return x * fast_sigmoid(2.0f * u); }
__device__ __forceinline__ float wave_sum(float v) {
#pragma unroll
    for (int o = 1; o < 64; o <<= 1) v += __shfl_xor(v, o);
    return v;
}
__device__ __forceinline__ v4u pack8(const f32x4 a, const f32x4 b) { v4u w; w.x = cvt_pk_bf16(a[0], a[1]); w.y = cvt_pk_bf16(a[2], a[3]); w.z = cvt_pk_bf16(b[0], b[1]); w.w = cvt_pk_bf16(b[2], b[3]); return w; }
__device__ __forceinline__ void unpack8(const v4u w, f32x4& a, f32x4& b) { a = (f32x4){bf_lo(w.x), bf_hi(w.x), bf_lo(w.y), bf_hi(w.y)}; b = (f32x4){bf_lo(w.z), bf_hi(w.z), bf_lo(w.w), bf_hi(w.w)}; }

#ifndef FP8_ASM_DMA
#define FP8_ASM_DMA 0
#endif
namespace pg8 {
constexpr int BM = 256, BK = 64, HALF = 128, HTB = HALF * BK * 2, STAGE_BYTES = 8 * HTB;
__host__ __device__ __forceinline__ int lds_byte(int r, int c) { const int st = (r >> 4) * 2 + (c >> 5), rr = r & 15, cc = c & 31, ob = rr * 64 + cc * 2; return st * 1024 + (ob ^ (((ob >> 9) & 1) << 5)); }
__host__ __device__ __forceinline__ void stage_rc(int b, int& R, int& C) { const int st = b / 1024, sb = b % 1024, swz = sb ^ (((sb >> 9) & 1) << 5); R = (st >> 1) * 16 + swz / 64; C = (st & 1) * 32 + (swz % 64) / 2; }
__host__ __device__ __forceinline__ int perm32(int rho) { const int n = rho >> 4, i = rho & 15; return 8 * (i >> 2) + 4 * n + (i & 3); }

__device__ __forceinline__ void glds16s(unsigned voff, const char* sbase, unsigned lds_dst) { unsigned keep;
    asm volatile("s_mov_b32 %0, m0\n\ts_mov_b32 m0, %3\n\ts_nop 0\n\tglobal_load_lds_dwordx4 %1, %2\n\ts_mov_b32 m0, %0" : "=&s"(keep) : "v"(voff), "s"(sbase), "s"(lds_dst) : "memory"); }
struct Unit { int pm, pn, tag, aux; const char* A; const char* B; };

template <class Epi, class Sched, bool ALIGN_EPI, bool GATHER, bool FP8 = false, bool MIX = false>
__device__ __forceinline__ void gemm_phase(LAS unsigned char* lds, const int wave_in, const int K, const int lda, const int ldb, const Sched& S, const Epi& E) {
    const int wid = wave_in, lane = lane_id(), tid = wid * 64 + lane,
              wr = wid >> 2, wc = wid & 3, fr = lane & 15, fq = lane >> 4;
    const int nt = K / BK;
    int Rr[2], Cc[2]; unsigned voffB[2], vA0[2], vA1[2], nA0[2], nA1[2];
#pragma unroll
    for (int i = 0; i < 2; ++i) { stage_rc(tid * 16 + i * 8192, Rr[i], Cc[i]); const int Rb = (Rr[i] & ~31) + perm32(Rr[i] & 31);
        voffB[i] = (unsigned)(Rb * ldb + Cc[i]) * 2u; vA0[i] = (unsigned)(Rr[i] * lda + Cc[i]) * 2u; vA1[i] = vA0[i]; nA0[i] = vA0[i]; nA1[i] = vA0[i]; }
    const size_t kstep = (size_t)(BK * 2);
    const size_t hstepA = GATHER ? (size_t)0 : (size_t)HALF * lda * 2, hstepB = (size_t)HALF * ldb * 2;
    const unsigned ldsw = (unsigned)wid * 1024u;
    const int sc1_ = 0x7F7F7F7F; (void)sc1_;
    const unsigned ldsb = (unsigned)(uintptr_t)lds; (void)ldsb;
    const int aoff = lds_byte(wr * 64 + fr, fq * 8), boff = lds_byte(wc * 32 + fr, fq * 8);
#define PG8_SA(b, h) (((b) * 2 + (h)) * HTB)
#define PG8_SB(b, h) ((4 + (b) * 2 + (h)) * HTB)
#define PG8_STAGE(bufoff, gbase, voff) do { _Pragma("unroll") for (int _i = 0; _i < 2; ++_i) { \
        if constexpr ((FP8 && FP8_ASM_DMA) || MIX) glds16s((voff)[_i], (const char*)(gbase), (unsigned)__builtin_amdgcn_readfirstlane((int)(ldsb + (unsigned)(bufoff) + ldsw + (unsigned)_i * 8192u))); \
        else __builtin_amdgcn_global_load_lds((const unsigned*)((const char*)(gbase) + (voff)[_i]), (LAS unsigned*)(lds + (bufoff) + ldsw + _i * 8192), 16, 0, 0); } } while (0)
#define PG8_LDA(dst, b, h) do { _Pragma("unroll") for (int m = 0; m < 4; ++m) _Pragma("unroll") for (int k = 0; k < 2; ++k) dst[m][k] = *(const LAS bf16x8*)(lds + PG8_SA(b, h) + aoff + m * 2048 + k * 1024); } while (0)
#define PG8_LDB(dst, b, h) do { _Pragma("unroll") for (int n = 0; n < 2; ++n) _Pragma("unroll") for (int k = 0; k < 2; ++k) dst[n][k] = *(const LAS bf16x8*)(lds + PG8_SB(b, h) + boff + n * 2048 + k * 1024); } while (0)
#define PG8_MMAX(F8, ai, bj, At, Bt) do { __builtin_amdgcn_s_setprio(1); _Pragma("unroll") for (int m = 0; m < 4; ++m) _Pragma("unroll") for (int n = 0; n < 2; ++n) { \
        if constexpr (F8) { const i32x4 b0_ = __builtin_bit_cast(i32x4, Bt[n][0]), b1_ = __builtin_bit_cast(i32x4, Bt[n][1]), a0_ = __builtin_bit_cast(i32x4, At[m][0]), a1_ = __builtin_bit_cast(i32x4, At[m][1]); \
            const i32x8 bv_ = {b0_[0], b0_[1], b0_[2], b0_[3], b1_[0], b1_[1], b1_[2], b1_[3]}, av_ = {a0_[0], a0_[1], a0_[2], a0_[3], a1_[0], a1_[1], a1_[2], a1_[3]}; \
            asm volatile("v_mfma_scale_f32_16x16x128_f8f6f4 %0, %1, %2, %0, %3, %3 op_sel_hi:[0,0,0]" : "+v"(acc[ai][bj][m][n]) : "v"(bv_), "v"(av_), "v"(sc1_)); } \
        else { _Pragma("unroll") for (int k = 0; k < 2; ++k) acc[ai][bj][m][n] = __builtin_amdgcn_mfma_f32_16x16x32_bf16(Bt[n][k], At[m][k], acc[ai][bj][m][n], 0, 0, 0); } } \
        __builtin_amdgcn_s_setprio(0); } while (0)
#define PG8_MMA(ai, bj, At, Bt) PG8_MMAX(FP8, ai, bj, At, Bt)
#define PG8_VA1 (GATHER ? vA1 : vA0)
#define PG8_S0 (GATHER ? s0 : vA0)
#define PG8_S1 (GATHER ? s1 : vA0)
#define PG8_WAIT_V(n) asm volatile("s_waitcnt vmcnt(" #n ")" ::: "memory")
#define PG8_WAIT_L(n) asm volatile("s_waitcnt lgkmcnt(" #n ")" ::: "memory")
#define PG8_BAR __builtin_amdgcn_s_barrier()
#define PG8_SCHED __builtin_amdgcn_sched_barrier(0)
#define PG8_KLOOP(F8, NTV) \
        for (int t = 0; t < (NTV); t += 2) { \
            const bool last = (t == (NTV) - 2); \
            const char* a1 = cA + (size_t)(t + 1) * kstep; \
            const char* a2 = last ? nA : cA + (size_t)(t + 2) * kstep; const char* b2 = last ? nB : cB + (size_t)(t + 2) * kstep; \
            const char* a3 = a2 + kstep; const char* b3 = b2 + kstep; \
            unsigned s0[2], s1[2]; \
            _Pragma("unroll") for (int i = 0; i < 2; ++i) { if constexpr (GATHER) { s0[i] = last ? nA0[i] : vA0[i]; s1[i] = last ? nA1[i] : vA1[i]; } else { s0[i] = vA0[i]; s1[i] = vA0[i]; } } \
            (void)s0; (void)s1; \
              \
            PG8_LDB(B0, 0, 0); PG8_LDB(B1, 0, 1); PG8_SCHED; PG8_LDA(At, 0, 0); PG8_STAGE(PG8_SA(1, 1), a1 + hstepA, PG8_VA1); \
            PG8_WAIT_V(8); PG8_WAIT_L(0); PG8_BAR; PG8_MMAX(F8, 0, 0, At, B0); PG8_MMAX(F8, 0, 1, At, B1); PG8_BAR; PG8_SCHED; \
            PG8_LDA(At, 0, 1); PG8_STAGE(PG8_SB(0, 0), b2, voffB); PG8_STAGE(PG8_SB(0, 1), b2 + hstepB, voffB); PG8_STAGE(PG8_SA(0, 0), a2, PG8_S0); \
            PG8_WAIT_V(8); PG8_WAIT_L(0); PG8_BAR; PG8_MMAX(F8, 1, 0, At, B0); PG8_MMAX(F8, 1, 1, At, B1); PG8_BAR; PG8_SCHED; \
              \
            PG8_LDB(B0, 1, 0); PG8_LDB(B1, 1, 1); PG8_SCHED; PG8_LDA(At, 1, 0); PG8_STAGE(PG8_SA(0, 1), a2 + hstepA, PG8_S1); \
            PG8_WAIT_V(8); PG8_WAIT_L(0); PG8_BAR; PG8_MMAX(F8, 0, 0, At, B0); PG8_MMAX(F8, 0, 1, At, B1); PG8_BAR; PG8_SCHED; \
            PG8_LDA(At, 1, 1); PG8_STAGE(PG8_SB(1, 0), b3, voffB); PG8_STAGE(PG8_SB(1, 1), b3 + hstepB, voffB); PG8_STAGE(PG8_SA(1, 0), a3, PG8_S0); \
            PG8_WAIT_V(8); PG8_WAIT_L(0); PG8_BAR; PG8_MMAX(F8, 1, 0, At, B0); PG8_MMAX(F8, 1, 1, At, B1); PG8_BAR; PG8_SCHED; \
        }
    Unit cur, nxt; int ui = 0;
    if (!S.next(0, cur)) return;
    if constexpr (GATHER) {
#pragma unroll
        for (int i = 0; i < 2; ++i) { vA0[i] = (unsigned)(S.grow(cur, Rr[i]) * lda + Cc[i]) * 2u; vA1[i] = (unsigned)(S.grow(cur, HALF + Rr[i]) * lda + Cc[i]) * 2u; }
    }
    f32x4 acc[2][2][4][2];
#pragma unroll
    for (int a = 0; a < 2; ++a)
#pragma unroll
        for (int b = 0; b < 2; ++b)
#pragma unroll
            for (int m = 0; m < 4; ++m)
#pragma unroll
                for (int n = 0; n < 2; ++n) acc[a][b][m][n] = (f32x4){0.f, 0.f, 0.f, 0.f};
    bf16x8 At[4][2], B0[2][2], B1[2][2];
    const char* cA = cur.A; const char* cB = cur.B;
    PG8_STAGE(PG8_SB(0, 0), cB, voffB); PG8_STAGE(PG8_SB(0, 1), cB + hstepB, voffB); PG8_STAGE(PG8_SA(0, 0), cA, vA0); PG8_STAGE(PG8_SA(0, 1), cA + hstepA, PG8_VA1);
    if (wr == 1) PG8_BAR;
    PG8_WAIT_V(2); PG8_BAR;
    PG8_STAGE(PG8_SB(1, 0), cB + kstep, voffB); PG8_STAGE(PG8_SA(1, 0), cA + kstep, vA0); PG8_STAGE(PG8_SB(1, 1), cB + hstepB + kstep, voffB);
    PG8_WAIT_V(6); PG8_BAR;
    for (;;) {
        const bool has_next = S.next(ui + 1, nxt);
        const char* nA = has_next ? nxt.A : cA; const char* nB = has_next ? nxt.B : cB;
        if constexpr (GATHER) {
            if (has_next) {
#pragma unroll
                for (int i = 0; i < 2; ++i) { nA0[i] = (unsigned)(S.grow(nxt, Rr[i]) * lda + Cc[i]) * 2u; nA1[i] = (unsigned)(S.grow(nxt, HALF + Rr[i]) * lda + Cc[i]) * 2u; }
            } else {
#pragma unroll
                for (int i = 0; i < 2; ++i) { nA0[i] = vA0[i]; nA1[i] = vA1[i]; }
            }
        }
        if constexpr (MIX) { if (cur.tag != 0) { PG8_KLOOP(true, nt >> 1); } else { PG8_KLOOP(false, nt); } }
        else { PG8_KLOOP(FP8, nt); }
        if constexpr (ALIGN_EPI) { if (wr == 0) PG8_BAR; }
        if constexpr (FP8 || MIX) asm volatile("s_nop 15\n\ts_nop 7" ::: "memory");
        if constexpr (!Epi::AFTER_DRAIN) { E(acc, cur, wr, wc, fr, fq); }
        if (!has_next) break;
#pragma unroll
        for (int a = 0; a < 2; ++a)
#pragma unroll
            for (int b = 0; b < 2; ++b)
#pragma unroll
                for (int m = 0; m < 4; ++m)
#pragma unroll
                    for (int n = 0; n < 2; ++n) acc[a][b][m][n] = (f32x4){0.f, 0.f, 0.f, 0.f};
        cur = nxt; cA = nA; cB = nB; ++ui;
        if constexpr (GATHER) {
#pragma unroll
            for (int i = 0; i < 2; ++i) { vA0[i] = nA0[i]; vA1[i] = nA1[i]; }
        }
        if constexpr (ALIGN_EPI) { if (wr == 1) PG8_BAR; }
    }
    PG8_WAIT_V(0);
    if constexpr (!ALIGN_EPI) { if (wr == 0) PG8_BAR; }
    PG8_BAR;
    if constexpr (Epi::AFTER_DRAIN) { E.fused(acc, cur, wr, wc, fr, fq, lds, wid, lane); }
#undef PG8_SA
#undef PG8_SB
#undef PG8_STAGE
#undef PG8_LDA
#undef PG8_LDB
#undef PG8_MMA
#undef PG8_MMAX
#undef PG8_KLOOP
#undef PG8_VA1
#undef PG8_S0
#undef PG8_S1
#undef PG8_WAIT_V
#undef PG8_WAIT_L
#undef PG8_BAR
#undef PG8_SCHED
}
}
typedef f32x4 Acc[2][2][4][2];

__device__ __forceinline__ float ssq16(const float* p) { const f32x4 a = *(const f32x4*)p, b = *(const f32x4*)(p + 4), c = *(const f32x4*)(p + 8), d = *(const f32x4*)(p + 12);
    return (((a[0] + a[1]) + (a[2] + a[3])) + ((b[0] + b[1]) + (b[2] + b[3]))) + (((c[0] + c[1]) + (c[2] + c[3])) + ((d[0] + d[1]) + (d[2] + d[3]))); }
struct SchedGrid2 {
    int G, c; int n0, nN0, nN1, ntot; const char *A0, *B0, *A1, *B1; size_t ta, tb; bool xcd;
    __device__ __forceinline__ bool next(int i, pg8::Unit& u) const {
        if (xcd) {
            const int x = c >> 5, q = i * 32 + (c & 31); if (q >= 16 * nN0) return false;
            const int g8 = q / (8 * nN0), r = q % (8 * nN0);
            u.pm = 16 * x + 8 * g8 + (r & 7); u.pn = r >> 3; u.tag = 0; u.aux = 0; u.A = A0 + (size_t)u.pm * ta; u.B = B0 + (size_t)u.pn * tb; return true;
        }
        int L = i * G + c; if (L >= ntot) return false;
        if (L < n0) { u.pm = L / nN0; u.pn = L % nN0; u.tag = 0; u.A = A0 + (size_t)u.pm * ta; u.B = B0 + (size_t)u.pn * tb; }
        else { L -= n0; u.pm = L / nN1; u.pn = L % nN1; u.tag = 1; u.A = A1 + (size_t)u.pm * ta; u.B = B1 + (size_t)u.pn * tb; }
        u.aux = 0; return true;
    }
    __device__ __forceinline__ int grow(const pg8::Unit&, int) const { return 0; }
};
__device__ __forceinline__ SchedGrid2 make_grid1(int G, int c, int nM, int nN, const void* A, const void* B, int lda, int ldb) {
    SchedGrid2 s; s.G = G; s.c = c; s.n0 = nM * nN; s.nN0 = nN; s.nN1 = 1; s.ntot = s.n0; s.A0 = (const char*)A; s.B0 = (const char*)B; s.A1 = s.A0; s.B1 = s.B0;
    s.ta = (size_t)256 * lda * 2; s.tb = (size_t)256 * ldb * 2; s.xcd = (G == 256 && nM == 128); return s;
}
__device__ __forceinline__ SchedGrid2 make_grid2(int G, int c, int nM0, int nN0, const void* A0, const void* B0, int nM1, int nN1, const void* A1, const void* B1, int lda, int ldb) {
    SchedGrid2 s; s.G = G; s.c = c; s.n0 = nM0 * nN0; s.nN0 = nN0; s.nN1 = nN1; s.ntot = s.n0 + nM1 * nN1; s.A0 = (const char*)A0; s.B0 = (const char*)B0; s.A1 = (const char*)A1; s.B1 = (const char*)B1;
    s.ta = (size_t)256 * lda * 2; s.tb = (size_t)256 * ldb * 2; s.xcd = false; return s;
}
struct SchedBranch {
    int G, c; const char *ws;
    __device__ __forceinline__ bool next(int i, pg8::Unit& u) const {
        const int j = i % 3, b = 2 - j; int pm, pn;
        if (G == 256) { const int x = c >> 5, q = (i / 3) * 32 + (c & 31); if (q >= 64) return false; const int g8 = q >> 5, r = q & 31; pm = 16 * x + 8 * g8 + (r & 7); pn = r >> 3; }
        else { const int tile = (i / 3) * G + c; if (tile >= (T / 256) * 4) return false; pm = tile >> 2; pn = tile & 3; }
        u.pm = pm; u.pn = pn; u.tag = b; u.aux = j;
        const size_t yo = b == 0 ? WS_GL : (b == 1 ? WS_YB : WS_YC8);
        u.A = ws + yo + (size_t)u.pm * 256 * 512 * 2; u.B = ws + WS_WBR + ((size_t)b * 1024 + u.pn * 256) * 512 * 2; return true;
    }
    __device__ __forceinline__ int grow(const pg8::Unit&, int) const { return 0; }
};
struct MoeTab { const LAS int* p;
    __device__ __forceinline__ int cnt(int e) const { return p[e]; }
    __device__ __forceinline__ int base(int e) const { return p[32 + e]; }
    __device__ __forceinline__ int ntile() const { return p[64]; }
    __device__ __forceinline__ int tile_e(int t) const { return p[128 + t]; }
    __device__ __forceinline__ int tile_r(int t) const { return p[128 + MAXTILES + t]; }
};
template <int NCOL, bool GATHERED>
struct SchedMoe {
    int G, c; MoeTab tab; const char* Abase; const char* Wbase; size_t wexp, wtile; const int* ltok;
    __device__ __forceinline__ bool next(int i, pg8::Unit& u) const {
        const int L = i * G + c, rt = L / NCOL; if (rt >= tab.ntile()) return false;
        const int e = tab.tile_e(rt), r = tab.tile_r(rt);
        u.pn = L % NCOL; u.tag = e; u.aux = r; u.pm = (tab.base(e) >> 8) + r;
        u.A = GATHERED ? Abase : Abase + (size_t)u.pm * 256 * DEXP;
        u.B = Wbase + (size_t)e * wexp + (size_t)u.pn * wtile; return true;
    }
    __device__ __forceinline__ int grow(const pg8::Unit& u, int r) const {
        const int p = u.aux * 256 + r; return p < tab.cnt(u.tag) ? ltok[u.tag * T + p] : 0;
    }
};

#define EPI_ROWS_BEGIN _Pragma("unroll") for (int ai = 0; ai < 2; ++ai) _Pragma("unroll") for (int m = 0; m < 4; ++m) { const int row = u.pm * 256 + ai * 128 + wr * 64 + m * 16 + fr;
#define EPI_ROWS_END }

struct EpiProj {
    static constexpr bool AFTER_DRAIN = false;
    bf16 *XL, *GL, *CQ, *CKV, *QM, *SG, *KB; float *ssq_q, *ssq_kv; const float *cosT, *sinT; bool side; int pn_off; float gscale;
    __device__ __forceinline__ void operator()(const Acc& acc, const pg8::Unit& u, int wr, int wc, int fr, int fq) const {
        const int pn = u.pn + pn_off, cl = wc * 32 + 8 * fq;
        if (PROBE_SKIP == 9 && side) {
            unsigned char* const tb = (unsigned char*)XL + ((size_t)(u.pm * 8 + pn) << 17) + (wr * 4 + wc) * 16384 + (fq * 16 + fr) * 16;
            EPI_ROWS_BEGIN
#pragma unroll
                for (int bj = 0; bj < 2; ++bj) *(v4u*)(tb + ((ai * 4 + m) * 2 + bj) * 1024) = pack8(acc[ai][bj][m][0], acc[ai][bj][m][1]); (void)row; EPI_ROWS_END
            return;
        }
        if (PROBE_SKIP == 10 && side) {
            EPI_ROWS_BEGIN
#pragma unroll
                for (int bj = 0; bj < 2; ++bj) *(v4u*)(XL + ((size_t)(u.pm * 8 + pn) << 16) + (size_t)(row & 255) * 256 + bj * 128 + cl) = pack8(acc[ai][bj][m][0], acc[ai][bj][m][1]); EPI_ROWS_END
            return;
        }
        if (PROBE_SKIP && PROBE_SKIP != 4 && PROBE_SKIP < 6 && side) return;
        if (DBG_OUT == 2) {
            EPI_ROWS_BEGIN
#pragma unroll
                for (int bj = 0; bj < 2; ++bj) *(v4u*)(XL + (size_t)row * 5120 + pn * 256 + bj * 128 + cl) = pack8(acc[ai][bj][m][0], acc[ai][bj][m][1]); EPI_ROWS_END
        } else if (pn < 2) {
            EPI_ROWS_BEGIN
#pragma unroll
                for (int bj = 0; bj < 2; ++bj) *(v4u*)(XL + (size_t)row * 512 + pn * 256 + bj * 128 + cl) = pack8(acc[ai][bj][m][0], acc[ai][bj][m][1]); EPI_ROWS_END
        } else if (pn < 4) {
            EPI_ROWS_BEGIN
#pragma unroll
                for (int bj = 0; bj < 2; ++bj) { f32x4 a = acc[ai][bj][m][0], b = acc[ai][bj][m][1];
#pragma unroll
                    for (int j = 0; j < 4; ++j) { a[j] = gelu_tanh(a[j]); b[j] = gelu_tanh(b[j]); }
                    *(v4u*)(GL + (size_t)row * 512 + (pn - 2) * 256 + bj * 128 + cl) = pack8(a, b); } EPI_ROWS_END
        } else if (pn == 4) {
            EPI_ROWS_BEGIN
                float s = 0.f;
#pragma unroll
                for (int bj = 0; bj < 2; ++bj) { const f32x4 a = acc[ai][bj][m][0] * gscale, b = acc[ai][bj][m][1] * gscale;
                    s += (a[0] * a[0] + a[1] * a[1]) + (a[2] * a[2] + a[3] * a[3]) + (b[0] * b[0] + b[1] * b[1]) + (b[2] * b[2] + b[3] * b[3]);
                    { v2u c8; c8.x = pk4_fp8(sat8(a[0] * CL8_SCALE), sat8(a[1] * CL8_SCALE), sat8(a[2] * CL8_SCALE), sat8(a[3] * CL8_SCALE)); c8.y = pk4_fp8(sat8(b[0] * CL8_SCALE), sat8(b[1] * CL8_SCALE), sat8(b[2] * CL8_SCALE), sat8(b[3] * CL8_SCALE));
                      *(v2u*)((unsigned char*)CQ + (size_t)row * 256 + bj * 128 + cl) = c8; } }
                s += __shfl_xor(s, 16); s += __shfl_xor(s, 32);
                if (fq == 0) ssq_q[row * 4 + wc] = s; EPI_ROWS_END
        } else if (pn == 5) {
            EPI_ROWS_BEGIN
                { const f32x4 a = acc[ai][0][m][0] * gscale, b = acc[ai][0][m][1] * gscale;
                  float s = (a[0] * a[0] + a[1] * a[1]) + (a[2] * a[2] + a[3] * a[3]) + (b[0] * b[0] + b[1] * b[1]) + (b[2] * b[2] + b[3] * b[3]);
                  { const f32x4 a1 = acc[ai][1][m][0] * gscale, b1 = acc[ai][1][m][1] * gscale; v2u c8;
                    c8.x = pk4_fp8(sat8(a[0] * CL8_SCALE), sat8(a[1] * CL8_SCALE), sat8(a[2] * CL8_SCALE), sat8(a[3] * CL8_SCALE)); c8.y = pk4_fp8(sat8(b[0] * CL8_SCALE), sat8(b[1] * CL8_SCALE), sat8(b[2] * CL8_SCALE), sat8(b[3] * CL8_SCALE));
                    *(v2u*)((unsigned char*)CKV + (size_t)row * 256 + cl) = c8;
                    c8.x = pk4_fp8(sat8(a1[0] * CL8_SCALE), sat8(a1[1] * CL8_SCALE), sat8(a1[2] * CL8_SCALE), sat8(a1[3] * CL8_SCALE)); c8.y = pk4_fp8(sat8(b1[0] * CL8_SCALE), sat8(b1[1] * CL8_SCALE), sat8(b1[2] * CL8_SCALE), sat8(b1[3] * CL8_SCALE));
                    *(v2u*)((unsigned char*)CKV + (size_t)row * 256 + 128 + cl) = c8; }
                  s += __shfl_xor(s, 16); s += __shfl_xor(s, 32);
                  if (fq == 0) ssq_kv[row * 4 + wc] = s; }
                if (wc == 0) {
                    const f32x4 a = acc[ai][1][m][0] * gscale, b = acc[ai][1][m][1] * gscale;
                    const f32x4 cs = *(const f32x4*)(cosT + (size_t)row * 16 + 4 * fq), sn = *(const f32x4*)(sinT + (size_t)row * 16 + 4 * fq);
                    f32x4 oa, ob;
                    oa[0] = a[0] * cs[0] - a[1] * sn[0]; oa[1] = a[1] * cs[0] + a[0] * sn[0]; oa[2] = a[2] * cs[1] - a[3] * sn[1]; oa[3] = a[3] * cs[1] + a[2] * sn[1];
                    ob[0] = b[0] * cs[2] - b[1] * sn[2]; ob[1] = b[1] * cs[2] + b[0] * sn[2]; ob[2] = b[2] * cs[3] - b[3] * sn[3]; ob[3] = b[3] * cs[3] + b[2] * sn[3];
                    *(v4u*)(KB + (size_t)row * 32 + 8 * fq) = pack8(oa, ob);
                } EPI_ROWS_END
        } else if (pn < 8) {
            EPI_ROWS_BEGIN
#pragma unroll
                for (int bj = 0; bj < 2; ++bj) *(v4u*)(QM + (size_t)row * 512 + (pn - 6) * 256 + bj * 128 + cl) = pack8(acc[ai][bj][m][0] * (C2_MEM * gscale), acc[ai][bj][m][1] * (C2_MEM * gscale)); EPI_ROWS_END
        } else {
            unsigned char* const sgl = (unsigned char*)SG + ((size_t)(u.pm * 12 + pn - 8) << 16);
            const unsigned lo = (unsigned)((((wr * 4 + wc) * 16) * 64 + fq * 16 + fr) << 3);
            EPI_ROWS_BEGIN
#pragma unroll
                for (int bj = 0; bj < 2; ++bj) { f32x4 a = acc[ai][bj][m][0], b = acc[ai][bj][m][1];
#pragma unroll
                    for (int j = 0; j < 4; ++j) { a[j] = fast_sigmoid(a[j] * gscale) * 255.0f + 0.5f; b[j] = fast_sigmoid(b[j] * gscale) * 255.0f + 0.5f; }
                    unsigned o = lo; asm volatile("" : "+v"(o)); unsigned char* const sp = sgl + o;
                    v2u w; w.x = (unsigned)a[0] | ((unsigned)a[1] << 8) | ((unsigned)a[2] << 16) | ((unsigned)a[3] << 24); w.y = (unsigned)b[0] | ((unsigned)b[1] << 8) | ((unsigned)b[2] << 16) | ((unsigned)b[3] << 24);
                    *(v2u*)(sp + ((ai * 4 + m) * 2 + bj) * 512) = w; (void)row; } EPI_ROWS_END
        }
    }
};
struct EpiGate {
    static constexpr bool AFTER_DRAIN = false;
    unsigned char* SG; float gscale; bool skip;
    __device__ __forceinline__ void operator()(const Acc& acc, const pg8::Unit& u, int wr, int wc, int fr, int fq) const {
        if (PROBE_SKIP && PROBE_SKIP < 5 && skip) return;
        unsigned char* const sgl = SG + ((size_t)(u.pm * 12 + u.pn) << 16);
        const unsigned lo = (unsigned)((((wr * 4 + wc) * 16) * 64 + fq * 16 + fr) << 3);
#pragma unroll
        for (int ai = 0; ai < 2; ++ai)
#pragma unroll
            for (int m = 0; m < 4; ++m)
#pragma unroll
                for (int bj = 0; bj < 2; ++bj) { f32x4 a = acc[ai][bj][m][0], b = acc[ai][bj][m][1];
#pragma unroll
                    for (int j = 0; j < 4; ++j) { a[j] = fast_sigmoid(a[j] * gscale) * 255.0f + 0.5f; b[j] = fast_sigmoid(b[j] * gscale) * 255.0f + 0.5f; }
                    unsigned o = lo; asm volatile("" : "+v"(o));
                    v2u w; w.x = (unsigned)a[0] | ((unsigned)a[1] << 8) | ((unsigned)a[2] << 16) | ((unsigned)a[3] << 24); w.y = (unsigned)b[0] | ((unsigned)b[1] << 8) | ((unsigned)b[2] << 16) | ((unsigned)b[3] << 24);
                    *(v2u*)(sgl + o + ((ai * 4 + m) * 2 + bj) * 512) = w; }
    }
};
struct EpiQ {
    static constexpr bool AFTER_DRAIN = false;
    bf16* Q; const float* ssq_q; const float *cosT, *sinT;
    __device__ __forceinline__ void operator()(const Acc& acc, const pg8::Unit& u, int wr, int wc, int fr, int fq) const {
        const int cl = wc * 32 + 8 * fq;
        EPI_ROWS_BEGIN
            const f32x4 sq4 = *(const f32x4*)(ssq_q + row * 4); const float rs = rsqrtf(((sq4[0] + sq4[1]) + (sq4[2] + sq4[3])) * (1.0f / 256.0f) + EPS) * (1.0f / (WU8_SCALE * CL8_SCALE));
#pragma unroll
            for (int bj = 0; bj < 2; ++bj) { const int c = u.pn * 256 + bj * 128 + cl, d = c % 96;
                f32x4 a = acc[ai][bj][m][0] * rs, b = acc[ai][bj][m][1] * rs;
                if (d >= 64) { const int i0 = (d - 64) >> 1;
                    const f32x4 cs = *(const f32x4*)(cosT + (size_t)row * 16 + i0), sn = *(const f32x4*)(sinT + (size_t)row * 16 + i0);
                    f32x4 oa, ob;
                    oa[0] = a[0] * cs[0] - a[1] * sn[0]; oa[1] = a[1] * cs[0] + a[0] * sn[0]; oa[2] = a[2] * cs[1] - a[3] * sn[1]; oa[3] = a[3] * cs[1] + a[2] * sn[1];
                    ob[0] = b[0] * cs[2] - b[1] * sn[2]; ob[1] = b[1] * cs[2] + b[0] * sn[2]; ob[2] = b[2] * cs[3] - b[3] * sn[3]; ob[3] = b[3] * cs[3] + b[2] * sn[3];
                    a = oa; b = ob; }
                *(v4u*)(Q + (size_t)row * 768 + c) = pack8(a * C2_MLA, b * C2_MLA); } EPI_ROWS_END
    }
};
struct EpiKV {
    static constexpr bool AFTER_DRAIN = false;
    bf16 *KB, *VT; const float* ssq_kv;
    __device__ __forceinline__ void operator()(const Acc& acc, const pg8::Unit& u, int wr, int wc, int fr, int fq) const {
        const int cl = wc * 32 + 8 * fq;
        if (u.tag == 0) {
            EPI_ROWS_BEGIN
                const f32x4 sq4 = *(const f32x4*)(ssq_kv + row * 4); const float rs = rsqrtf(((sq4[0] + sq4[1]) + (sq4[2] + sq4[3])) * (1.0f / 128.0f) + EPS) * (1.0f / (WU8_SCALE * CL8_SCALE));
#pragma unroll
                for (int bj = 0; bj < 2; ++bj) { const int c = u.pn * 256 + bj * 128 + cl;
                    *(v4u*)(KB + (size_t)row * 512 + c) = pack8(acc[ai][bj][m][0] * rs, acc[ai][bj][m][1] * rs); } EPI_ROWS_END
        } else {
            f32x4 rsa[2], rsb[2]; size_t cb[2];
#pragma unroll
            for (int bj = 0; bj < 2; ++bj) { const int t0 = u.pn * 256 + bj * 128 + cl;
#pragma unroll
                for (int j = 0; j < 4; ++j) { const f32x4 qa = *(const f32x4*)(ssq_kv + (t0 + j) * 4), qb = *(const f32x4*)(ssq_kv + (t0 + 4 + j) * 4);
                    rsa[bj][j] = rsqrtf(((qa[0] + qa[1]) + (qa[2] + qa[3])) * (1.0f / 128.0f) + EPS) * (1.0f / (WU8_SCALE * CL8_SCALE)); rsb[bj][j] = rsqrtf(((qb[0] + qb[1]) + (qb[2] + qb[3])) * (1.0f / 128.0f) + EPS) * (1.0f / (WU8_SCALE * CL8_SCALE)); }
                cb[bj] = (size_t)(t0 >> 12) * 512 * 4096 + (t0 & 4095); }
            EPI_ROWS_BEGIN
#pragma unroll
                for (int bj = 0; bj < 2; ++bj) *(v4u*)(VT + cb[bj] + (size_t)row * 4096) = pack8(acc[ai][bj][m][0] * rsa[bj], acc[ai][bj][m][1] * rsb[bj]); EPI_ROWS_END
        }
    }
};
struct EpiMem {
    static constexpr bool AFTER_DRAIN = false;
    bf16 *MK, *MVT;
    __device__ __forceinline__ void operator()(const Acc& acc, const pg8::Unit& u, int wr, int wc, int fr, int fq) const {
        const int cl = wc * 32 + 8 * fq;
        if (u.tag == 0) {
            EPI_ROWS_BEGIN
#pragma unroll
                for (int bj = 0; bj < 2; ++bj) *(v4u*)(MK + (size_t)row * 512 + u.pn * 256 + bj * 128 + cl) = pack8(acc[ai][bj][m][0], acc[ai][bj][m][1]); EPI_ROWS_END
        } else {
            EPI_ROWS_BEGIN
#pragma unroll
                for (int bj = 0; bj < 2; ++bj) *(v4u*)(MVT + ((size_t)u.pn * 512 + row) * 256 + bj * 128 + cl) = pack8(acc[ai][bj][m][0], acc[ai][bj][m][1]); EPI_ROWS_END
        }
    }
};
struct EpiBranch {
    static constexpr bool AFTER_DRAIN = false;
    const bf16* SG; bf16* MG;
    mutable v2u hold[16];
    template <int ST>
    __device__ __forceinline__ void stage(const Acc& acc, const pg8::Unit& u, int wr, int wc, int fr_, int fq_) const {
        constexpr int b = 2 - ST;
        const int ln = lane_id(); (void)fr_; (void)fq_;
        const int fr = ln & 15, fq = ln >> 4, cl = wc * 32 + 8 * fq;
        const size_t lb = (size_t)((((wr * 4 + wc) * 16) * 64 + fq * 16 + fr) << 3);
        const unsigned char* const gl = (const unsigned char*)SG + ((size_t)(u.pm * 12 + b * 4 + u.pn) << 16) + lb;
        constexpr float q = b ? (1.0f / 255.0f) / (WB8_SCALE * Y8_SCALE) : 1.0f / 255.0f;
#pragma unroll
        for (int ai = 0; ai < 2; ++ai) {
            v2u gw[4][2];
#pragma unroll
            for (int m = 0; m < 4; ++m)
#pragma unroll
                for (int bj = 0; bj < 2; ++bj) gw[m][bj] = *(const v2u*)(gl + ((ai * 4 + m) * 2 + bj) * 512);
#pragma unroll
            for (int m = 0; m < 4; ++m) { const int row = u.pm * 256 + ai * 128 + wr * 64 + m * 16 + fr;
#pragma unroll
                for (int bj = 0; bj < 2; ++bj) { const int c = u.pn * 256 + bj * 128 + cl, k = (ai * 4 + m) * 2 + bj;
                    f32x4 ga, gb;
                    { const unsigned g0 = gw[m][bj].x, g1 = gw[m][bj].y;
                      ga = (f32x4){(float)(g0 & 255u) * q, (float)((g0 >> 8) & 255u) * q, (float)((g0 >> 16) & 255u) * q, (float)(g0 >> 24) * q};
                      gb = (f32x4){(float)(g1 & 255u) * q, (float)((g1 >> 8) & 255u) * q, (float)((g1 >> 16) & 255u) * q, (float)(g1 >> 24) * q}; }
                    f32x4 a = acc[ai][bj][m][0] * ga, bb = acc[ai][bj][m][1] * gb;
                    if (!((DBG_BR >> b) & 1)) { a = (f32x4){0.f, 0.f, 0.f, 0.f}; bb = a; }
                    if constexpr (ST > 0) { const f32x2 h0 = __builtin_amdgcn_cvt_pk_f32_fp8((int)hold[k].x, false), h1 = __builtin_amdgcn_cvt_pk_f32_fp8((int)hold[k].x, true), h2 = __builtin_amdgcn_cvt_pk_f32_fp8((int)hold[k].y, false), h3 = __builtin_amdgcn_cvt_pk_f32_fp8((int)hold[k].y, true);
                        a += (f32x4){h0[0], h0[1], h1[0], h1[1]}; bb += (f32x4){h2[0], h2[1], h3[0], h3[1]}; }
                    if constexpr (ST < 2) { hold[k].x = pk4_fp8(a[0], a[1], a[2], a[3]); hold[k].y = pk4_fp8(bb[0], bb[1], bb[2], bb[3]); }
                    else *(v4u*)(MG + (size_t)row * 1024 + c) = pack8(a, bb); } }
        }
    }
    __device__ __forceinline__ void operator()(const Acc& acc, const pg8::Unit& u, int wr, int wc, int fr, int fq) const {
        if (u.aux == 0) stage<0>(acc, u, wr, wc, fr, fq); else if (u.aux == 1) stage<1>(acc, u, wr, wc, fr, fq); else stage<2>(acc, u, wr, wc, fr, fq);
    }
};
struct EpiWo {
    static constexpr bool AFTER_DRAIN = false;
    const float* x; float* out; bf16* HB; float* ssq_h; bool side; unsigned char* HB8;
    __device__ __forceinline__ void operator()(const Acc& acc, const pg8::Unit& u, int wr, int wc, int fr, int fq) const {
        const int cl = wc * 32 + 8 * fq;
        f32x4 xa[2][2][2], xb[2][2][2];
#define WO_LOAD(k) do { _Pragma("unroll") for (int mm = 0; mm < 2; ++mm) _Pragma("unroll") for (int bj = 0; bj < 2; ++bj) { \
            const size_t off = (size_t)(u.pm * 256 + ((k) >> 1) * 128 + wr * 64 + (((k) & 1) * 2 + mm) * 16 + fr) * 1024 + u.pn * 256 + bj * 128 + cl; \
            xa[(k) & 1][mm][bj] = *(const f32x4*)(x + off); xb[(k) & 1][mm][bj] = *(const f32x4*)(x + off + 4); } } while (0)
        WO_LOAD(0);
#pragma unroll
        for (int k = 0; k < 4; ++k) { const int ai = k >> 1, mh = k & 1;
                if (k < 3) WO_LOAD(k + 1);
#pragma unroll
                for (int mm = 0; mm < 2; ++mm) { const int m = mh * 2 + mm, row = u.pm * 256 + ai * 128 + wr * 64 + m * 16 + fr; float s = 0.f;
#pragma unroll
                    for (int bj = 0; bj < 2; ++bj) { const size_t off = (size_t)row * 1024 + u.pn * 256 + bj * 128 + cl;
                        const f32x4 a = xa[k & 1][mm][bj] + acc[ai][bj][m][0], b = xb[k & 1][mm][bj] + acc[ai][bj][m][1];
                        *(v4u*)(HB + off) = pack8(a, b); { v2u h8; h8.x = pk4_fp8(a[0], a[1], a[2], a[3]); h8.y = pk4_fp8(b[0], b[1], b[2], b[3]); *(v2u*)(HB8 + off) = h8; }
                        s += (a[0] * a[0] + a[1] * a[1]) + (a[2] * a[2] + a[3] * a[3]) + (b[0] * b[0] + b[1] * b[1]) + (b[2] * b[2] + b[3] * b[3]); }
                    s += __shfl_xor(s, 16); s += __shfl_xor(s, 32);
                    if (fq == 0) ssq_h[row * 16 + u.pn * 4 + wc] = s; }
        }
#undef WO_LOAD
    }
};
struct EpiRouter {
    static constexpr bool AFTER_DRAIN = true;
    const float* ssq_h; const float *b_group, *b_router; unsigned* gcnt; int* ltok; float* lw; int* pick; float* rsh;
    __device__ __forceinline__ void fused(Acc& acc, const pg8::Unit& u, int wr, int wc, int fr, int fq, LAS unsigned char* lds, int wid, int lane) const {
        LAS unsigned* lcnt = (LAS unsigned*)lds; LAS unsigned* lbase = lcnt + 32;
        const int tix = wid * 64 + lane;
        if (tix < 32) lcnt[tix] = 0u;
        __syncthreads();
        int pe0[8], pe1[8], pp0[8], pp1[8]; float pw0[8], pw1[8];
        if (wc == 0) {
            const f32x4 bg = *(const f32x4*)b_group;
#pragma unroll
            for (int ai = 0; ai < 2; ++ai)
#pragma unroll
                for (int m = 0; m < 4; ++m) {
                    const int row = u.pm * 256 + ai * 128 + wr * 64 + m * 16 + fr, k = ai * 4 + m;
                    const float rs = rsqrtf(ssq16(ssq_h + row * 16) * (1.0f / 1024.0f) + EPS);
                    if (fq == 0) rsh[row] = rs;
                    const f32x4 gl = acc[ai][1][m][0] * rs + bg;
                    int g = 0; float gm = gl[0];
#pragma unroll
                    for (int j = 1; j < 4; ++j) if (gl[j] > gm) { gm = gl[j]; g = j; }
                    float den = 0.f;
#pragma unroll
                    for (int j = 0; j < 4; ++j) den += __expf(gl[j] - gm);
                    float gwt = 1.0f / den;
                    g = __shfl(g, fr); gwt = __shfl(gwt, fr);
                    const f32x4 ba = *(const f32x4*)(b_router + 8 * fq), bb = *(const f32x4*)(b_router + 8 * fq + 4);
                    const f32x4 la = acc[ai][0][m][0] * rs + ba, lb = acc[ai][0][m][1] * rs + bb;
                    float v[8] = {la[0], la[1], la[2], la[3], lb[0], lb[1], lb[2], lb[3]};
                    int i1 = 0; float v1 = v[0];
#pragma unroll
                    for (int j = 1; j < 8; ++j) if (v[j] > v1) { v1 = v[j]; i1 = j; }
                    int i2 = -1; float v2 = -INFINITY;
#pragma unroll
                    for (int j = 0; j < 8; ++j) if (j != i1 && v[j] > v2) { v2 = v[j]; i2 = j; }
                    const float w1 = gwt / (1.0f + __expf(v2 - v1)), w2 = gwt - w1;
                    pe0[k] = -1; pe1[k] = -1; pp0[k] = 0; pp1[k] = 0; pw0[k] = w1; pw1[k] = w2;
                    if (fq == g) { pe0[k] = 8 * g + i1; pe1[k] = 8 * g + i2;
                        pp0[k] = (int)__hip_atomic_fetch_add(lcnt + pe0[k], 1u, __ATOMIC_RELAXED, __HIP_MEMORY_SCOPE_WORKGROUP);
                        pp1[k] = (int)__hip_atomic_fetch_add(lcnt + pe1[k], 1u, __ATOMIC_RELAXED, __HIP_MEMORY_SCOPE_WORKGROUP); }
                }
        }
        __syncthreads();
        if (tix < 32) { const unsigned n = lcnt[tix]; lbase[tix] = n ? __hip_atomic_fetch_add(gcnt + tix, n, RLX_AGENT) : 0u; }
        __syncthreads();
        if (wc == 0) {
#pragma unroll
            for (int ai = 0; ai < 2; ++ai)
#pragma unroll
                for (int m = 0; m < 4; ++m) {
                    const int row = u.pm * 256 + ai * 128 + wr * 64 + m * 16 + fr, k = ai * 4 + m;
                    if (pe0[k] >= 0) {
                        const int e0 = pe0[k], e1 = pe1[k], s0 = (int)lbase[e0] + pp0[k], s1 = (int)lbase[e1] + pp1[k];
                        ltok[e0 * T + s0] = row; lw[e0 * T + s0] = pw0[k]; ltok[e1 * T + s1] = row; lw[e1 * T + s1] = pw1[k];
                        pick[row * 2] = (e0 << 16) | s0; pick[row * 2 + 1] = (e1 << 16) | s1;
                    }
                }
        }
    }
};
struct EpiE1 {
    static constexpr bool AFTER_DRAIN = false;
    const float* rsh; const int* ltok; bf16* HD; MoeTab tab;
    __device__ __forceinline__ void operator()(const Acc& acc, const pg8::Unit& u, int wr, int wc, int fr, int fq) const {
        const int cl = wc * 32 + 8 * fq, e = u.tag, cnt = tab.cnt(e);
        const int ln = lane_id();
        unsigned char* const hdl = (unsigned char*)HD + (size_t)(u.pm * 256 + wr * 64 + (ln & 15)) * 256 + u.pn * 128 + wc * 32 + 8 * (ln >> 4);
        int tok[8]; float sq[8];
#pragma unroll
        for (int k = 0; k < 8; ++k) { const int p = u.aux * 256 + (k >> 2) * 128 + wr * 64 + (k & 3) * 16 + fr; tok[k] = p < cnt ? ltok[e * T + p] : 0; }
#pragma unroll
        for (int k = 0; k < 8; ++k) sq[k] = rsh[tok[k]];
        EPI_ROWS_BEGIN
            const int p = u.aux * 256 + ai * 128 + wr * 64 + m * 16 + fr;
            if (p < cnt) { const float rs = sq[ai * 4 + m] * (1.0f / W18_SCALE);
                f32x4 a, b;
#pragma unroll
                for (int j = 0; j < 4; ++j) { const float g0 = acc[ai][0][m][0][j] * rs, u0 = acc[ai][1][m][0][j] * rs, g1 = acc[ai][0][m][1][j] * rs, u1 = acc[ai][1][m][1][j] * rs;
                    a[j] = g0 * fast_sigmoid(g0) * u0; b[j] = g1 * fast_sigmoid(g1) * u1; }
                v2u h8; h8.x = pk4_fp8(sat8(a[0] * HD8_SCALE), sat8(a[1] * HD8_SCALE), sat8(a[2] * HD8_SCALE), sat8(a[3] * HD8_SCALE)); h8.y = pk4_fp8(sat8(b[0] * HD8_SCALE), sat8(b[1] * HD8_SCALE), sat8(b[2] * HD8_SCALE), sat8(b[3] * HD8_SCALE));
                *(v2u*)(hdl + (size_t)(ai * 128 + m * 16) * 256) = h8; (void)row; } EPI_ROWS_END
    }
};
struct EpiE2 {
    static constexpr bool AFTER_DRAIN = false;
    const float* lw; unsigned char* YE; MoeTab tab;
    __device__ __forceinline__ void operator()(const Acc& acc, const pg8::Unit& u, int wr, int wc, int fr, int fq) const {
        const int cl = wc * 32 + 8 * fq, e = u.tag, cnt = tab.cnt(e);
        EPI_ROWS_BEGIN
            const int p = u.aux * 256 + ai * 128 + wr * 64 + m * 16 + fr;
            if (p < cnt) { const float w = lw[e * T + p] * (1.0f / (W28_SCALE * HD8_SCALE));
#pragma unroll
                for (int bj = 0; bj < 2; ++bj) { const f32x4 a = acc[ai][bj][m][0] * w, b = acc[ai][bj][m][1] * w; v2u y8; y8.x = pk4_fp8(a[0], a[1], a[2], a[3]); y8.y = pk4_fp8(b[0], b[1], b[2], b[3]);
                    *(v2u*)(YE + (size_t)row * 1024 + u.pn * 256 + bj * 128 + cl) = y8; } } EPI_ROWS_END
    }
};

namespace att {
__device__ __forceinline__ float pmax(float m) { auto rr = __builtin_amdgcn_permlane32_swap(__float_as_uint(m), __float_as_uint(m), false, false); return fmaxf(__uint_as_float(rr[0]), __uint_as_float(rr[1])); }
__device__ __forceinline__ float psum(float m) { auto rr = __builtin_amdgcn_permlane32_swap(__float_as_uint(m), __float_as_uint(m), false, false); return __uint_as_float(rr[0]) + __uint_as_float(rr[1]); }
template <int DQK, int DV, bool CAUSAL, bool O8 = false>
__device__ __forceinline__ void unit(LAS unsigned char* lds, const int wave_in, const bf16* Qp, int qp, const bf16* Kp, int kp, const bf16* Vp, int vp, bf16* Op, int op, int q0, int NT) {
    constexpr int KST = DQK * 2 + 16, VST = 144, KBUF = 64 * KST, VBUF = DV * VST;
    constexpr int NCK = DQK / 8, TOTK = 64 * NCK, TOTV = DV * 8, NKI = (TOTK + 511) / 512, NVI = (TOTV + 511) / 512, ND0 = DQK / 16, NDT = DV / 32;
    const int wid = wave_in, lane = lane_id(), tid = wid * 64 + lane, r32 = lane & 31, hi = lane >> 5;
    const bf16* ksrc[NKI]; int kdst[NKI]; bool kval[NKI]; const bf16* vsrc[NVI]; int vdst[NVI];
#pragma unroll
    for (int i = 0; i < NKI; ++i) { const int id = tid + 512 * i; kval[i] = id < TOTK; const int idc = kval[i] ? id : 0, kr = idc / NCK, j = idc % NCK;
        const int rho = (kr & ~12) | ((kr & 4) << 1) | ((kr & 8) >> 1);
        ksrc[i] = Kp + (size_t)kr * kp + 8 * j; kdst[i] = rho * KST + 16 * j; }
#pragma unroll
    for (int i = 0; i < NVI; ++i) { const int id = tid + 512 * i, d = id >> 3, j = id & 7; vsrc[i] = Vp + (size_t)d * vp + 8 * j; vdst[i] = d * VST + 16 * j; }
    v4u kreg[NKI], vreg[NVI];
#define ATT_LOAD(t) do { _Pragma("unroll") for (int i = 0; i < NKI; ++i) kreg[i] = kval[i] ? *(const v4u*)(ksrc[i] + (size_t)(t) * 64 * kp) : (v4u){0u, 0u, 0u, 0u}; \
                         _Pragma("unroll") for (int i = 0; i < NVI; ++i) vreg[i] = *(const v4u*)(vsrc[i] + (size_t)(t) * 64); } while (0)
#define ATT_STORE(b) do { _Pragma("unroll") for (int i = 0; i < NKI; ++i) if (kval[i]) *(LAS v4u*)(lds + (b) * KBUF + kdst[i]) = kreg[i]; \
                          _Pragma("unroll") for (int i = 0; i < NVI; ++i) *(LAS v4u*)(lds + 2 * KBUF + (b) * VBUF + vdst[i]) = vreg[i]; } while (0)
    ATT_LOAD(0);
    bf16x8 qr[ND0];
    { const bf16* qrow = Qp + (size_t)(32 * wid + r32) * qp + hi * 8;
#pragma unroll
      for (int d0 = 0; d0 < ND0; ++d0) qr[d0] = *(const bf16x8*)(qrow + d0 * 16); }
    ATT_STORE(0);
    __syncthreads();
    f32x16 o[NDT];
#pragma unroll
    for (int dt = 0; dt < NDT; ++dt)
#pragma unroll
        for (int r = 0; r < 16; ++r) o[dt][r] = 0.f;
    float mrun = -INFINITY, lsum = 0.f;
    const int qbase = q0 + 32 * wid, qrow_i = qbase + r32;
    for (int t = 0; t < NT; ++t) {
        const int b = t & 1;
        if (t + 1 < NT) ATT_LOAD(t + 1);
        if (!CAUSAL || 64 * t <= qbase + 31) {
            const LAS unsigned char* kb = lds + b * KBUF + r32 * KST + hi * 16;
            f32x16 p0, p1;
#pragma unroll
            for (int r = 0; r < 16; ++r) { p0[r] = 0.f; p1[r] = 0.f; }
#pragma unroll
            for (int d0 = 0; d0 < ND0; ++d0) {
                const bf16x8 a0 = *(const LAS bf16x8*)(kb + d0 * 32), a1 = *(const LAS bf16x8*)(kb + 32 * KST + d0 * 32);
                p0 = __builtin_amdgcn_mfma_f32_32x32x16_bf16(a0, qr[d0], p0, 0, 0, 0);
                p1 = __builtin_amdgcn_mfma_f32_32x32x16_bf16(a1, qr[d0], p1, 0, 0, 0);
                if (DQK > 96 && (d0 & 1)) __builtin_amdgcn_sched_barrier(0);
            }
            if (CAUSAL && 64 * t + 63 > qbase) {
#pragma unroll
                for (int r = 0; r < 16; ++r) { const int key = 64 * t + 16 * (r >> 3) + 8 * hi + (r & 7);
                    if (key > qrow_i) p0[r] = -INFINITY; if (key + 32 > qrow_i) p1[r] = -INFINITY; }
            }
            float mt = fmaxf(p0[0], p1[0]);
#pragma unroll
            for (int r = 1; r < 16; ++r) mt = fmaxf(mt, fmaxf(p0[r], p1[r]));
            mt = pmax(mt);
            const float mnew = fmaxf(mrun, mt), sc = __builtin_amdgcn_exp2f(mrun - mnew);
            mrun = mnew;
            float ps = 0.f;
#pragma unroll
            for (int r = 0; r < 16; ++r) { p0[r] = __builtin_amdgcn_exp2f(p0[r] - mnew); p1[r] = __builtin_amdgcn_exp2f(p1[r] - mnew); ps += p0[r] + p1[r]; }
            lsum = lsum * sc + ps;
#pragma unroll
            for (int dt = 0; dt < NDT; ++dt)
#pragma unroll
                for (int r = 0; r < 16; ++r) o[dt][r] *= sc;
            bf16x8 pf[4];
            { v4u w;
              w.x = cvt_pk_bf16(p0[0], p0[1]); w.y = cvt_pk_bf16(p0[2], p0[3]); w.z = cvt_pk_bf16(p0[4], p0[5]); w.w = cvt_pk_bf16(p0[6], p0[7]); pf[0] = __builtin_bit_cast(bf16x8, w);
              w.x = cvt_pk_bf16(p0[8], p0[9]); w.y = cvt_pk_bf16(p0[10], p0[11]); w.z = cvt_pk_bf16(p0[12], p0[13]); w.w = cvt_pk_bf16(p0[14], p0[15]); pf[1] = __builtin_bit_cast(bf16x8, w);
              w.x = cvt_pk_bf16(p1[0], p1[1]); w.y = cvt_pk_bf16(p1[2], p1[3]); w.z = cvt_pk_bf16(p1[4], p1[5]); w.w = cvt_pk_bf16(p1[6], p1[7]); pf[2] = __builtin_bit_cast(bf16x8, w);
              w.x = cvt_pk_bf16(p1[8], p1[9]); w.y = cvt_pk_bf16(p1[10], p1[11]); w.z = cvt_pk_bf16(p1[12], p1[13]); w.w = cvt_pk_bf16(p1[14], p1[15]); pf[3] = __builtin_bit_cast(bf16x8, w); }
            const LAS unsigned char* vb = lds + 2 * KBUF + b * VBUF + r32 * VST + hi * 16;
#pragma unroll
            for (int dt = 0; dt < NDT; ++dt)
#pragma unroll
                for (int s = 0; s < 4; ++s) {
                    const bf16x8 vf = *(const LAS bf16x8*)(vb + dt * 32 * VST + s * 32);
                    o[dt] = __builtin_amdgcn_mfma_f32_32x32x16_bf16(vf, pf[s], o[dt], 0, 0, 0);
                    if (DV > 64 && s == 3) __builtin_amdgcn_sched_barrier(0);
                }
        }
        if (t + 1 < NT) ATT_STORE(b ^ 1);
        __syncthreads();
    }
    const float lt = psum(lsum), inv = 1.0f / lt;
    if constexpr (O8) {
        unsigned char* orow8 = (unsigned char*)Op + (size_t)(32 * wid + r32) * op + 4 * hi; const float i8 = inv * Y8_SCALE;
#pragma unroll
        for (int dt = 0; dt < NDT; ++dt)
#pragma unroll
            for (int g = 0; g < 4; ++g) *(unsigned*)(orow8 + 32 * dt + 8 * g) = pk4_fp8(sat8(o[dt][4 * g] * i8), sat8(o[dt][4 * g + 1] * i8), sat8(o[dt][4 * g + 2] * i8), sat8(o[dt][4 * g + 3] * i8));
    } else {
    bf16* orow = Op + (size_t)(32 * wid + r32) * op + 4 * hi;
#pragma unroll
    for (int dt = 0; dt < NDT; ++dt)
#pragma unroll
        for (int g = 0; g < 4; ++g) { v2u w; w.x = cvt_pk_bf16(o[dt][4 * g] * inv, o[dt][4 * g + 1] * inv); w.y = cvt_pk_bf16(o[dt][4 * g + 2] * inv, o[dt][4 * g + 3] * inv);
            *(v2u*)(orow + 32 * dt + 8 * g) = w; }
    }
#undef ATT_LOAD
#undef ATT_STORE
}
__device__ __forceinline__ float max3f(float a, float b, float c) { float r; asm("v_max3_f32 %0, %1, %2, %3" : "=v"(r) : "v"(a), "v"(b), "v"(c)); return r; }
template <int DQK, int DV, bool CAUSAL, int VARIANT = 0>
__device__ __forceinline__ void unit_f(LAS unsigned char* lds, const int wave_in, const bf16* Qp, int qp, const bf16* Kp, int kp, const bf16* Vp, int vp, bf16* Op, int op, int q0, int NT) {
    constexpr int KST = DQK * 2 + 16, VST = 144, KBUF = 64 * KST, VBUF = DV * VST;
    constexpr int NCK = DQK / 8, TOTV = DV * 8, NVI = (TOTV + 511) / 512, ND0 = DQK / 16, NDT = DV / 32;
    static_assert(NCK > 8 && NCK <= 16, "unit_f: K rows of 9..16 chunks");
    const int wid = wave_in, lane = lane_id(), tid = wid * 64 + lane, r32 = lane & 31, hi = lane >> 5;
    const int krow = tid >> 3, kj = tid & 7; const bool kval1 = kj + 8 < NCK;
    const int rho = (krow & ~12) | ((krow & 4) << 1) | ((krow & 8) >> 1);
    const bf16* ksrc0 = Kp + (size_t)krow * kp + 8 * kj; const int kdst0 = rho * KST + 16 * kj;
    const bf16* vsrc[NVI]; int vdst[NVI];
#pragma unroll
    for (int i = 0; i < NVI; ++i) { const int id = tid + 512 * i, d = id >> 3, j = id & 7; vsrc[i] = Vp + (size_t)d * vp + 8 * j; vdst[i] = d * VST + 16 * j; }
    v4u kregA[2], vregA[NVI], kregB[2], vregB[NVI];
#define ATF_LOAD(KR, VR, t) do { KR[0] = *(const v4u*)(ksrc0 + (size_t)(t) * 64 * kp); KR[1] = kval1 ? *(const v4u*)(ksrc0 + (size_t)(t) * 64 * kp + 64) : (v4u){0u, 0u, 0u, 0u}; \
                         _Pragma("unroll") for (int i = 0; i < NVI; ++i) VR[i] = *(const v4u*)(vsrc[i] + (size_t)(t) * 64); } while (0)
#define ATF_STORE(KR, VR, b) do { *(LAS v4u*)(lds + (b) * KBUF + kdst0) = KR[0]; if (kval1) *(LAS v4u*)(lds + (b) * KBUF + kdst0 + 128) = KR[1]; \
                          _Pragma("unroll") for (int i = 0; i < NVI; ++i) *(LAS v4u*)(lds + 2 * KBUF + (b) * VBUF + vdst[i]) = VR[i]; } while (0)
    ATF_LOAD(kregA, vregA, 0);
    if (NT > 1) ATF_LOAD(kregB, vregB, 1);
    bf16x8 qr[ND0];
    { const bf16* qrow = Qp + (size_t)(32 * wid + r32) * qp + hi * 8;
#pragma unroll
      for (int d0 = 0; d0 < ND0; ++d0) qr[d0] = *(const bf16x8*)(qrow + d0 * 16); }
    ATF_STORE(kregA, vregA, 0);
    __syncthreads();
    f32x16 o[NDT];
#pragma unroll
    for (int dt = 0; dt < NDT; ++dt)
#pragma unroll
        for (int r = 0; r < 16; ++r) o[dt][r] = 0.f;
    float mrun = 0.f, lsum = 0.f;
    f32x16 negm;
#pragma unroll
    for (int r = 0; r < 16; ++r) negm[r] = 0.f;
    const int qbase = q0 + 32 * wid, qrow_i = qbase + r32;
#define ATF_ITER(t, LK, LV, SK, SV) do { const int b = (t) & 1; \
        if (VARIANT != 3 && (t) + 2 < NT) ATF_LOAD(LK, LV, (t) + 2); \
        if (!CAUSAL || 64 * t <= qbase + 31) { \
            const LAS unsigned char* kb = lds + b * KBUF + r32 * KST + hi * 16; \
            f32x16 p0 = negm, p1 = negm; \
            _Pragma("unroll") \
            for (int d0 = 0; d0 < ND0; ++d0) { \
                const bf16x8 a0 = *(const LAS bf16x8*)(kb + d0 * 32), a1 = *(const LAS bf16x8*)(kb + 32 * KST + d0 * 32); \
                if (VARIANT != 2) { p0 = __builtin_amdgcn_mfma_f32_32x32x16_bf16(a0, qr[d0], p0, 0, 0, 0); \
                p1 = __builtin_amdgcn_mfma_f32_32x32x16_bf16(a1, qr[d0], p1, 0, 0, 0); } else { p0[d0] += __builtin_bit_cast(float, (int)a0[0]); p1[d0] += __builtin_bit_cast(float, (int)a1[0]); } \
            } \
            asm volatile("s_nop 15\n\ts_nop 7" : "+v"(p0), "+v"(p1)); \
            if (CAUSAL && 64 * t + 63 > qbase) { \
            _Pragma("unroll") \
                for (int r = 0; r < 16; ++r) { const int key = 64 * t + 16 * (r >> 3) + 8 * hi + (r & 7); \
                    if (key > qrow_i) p0[r] = -INFINITY; if (key + 32 > qrow_i) p1[r] = -INFINITY; } \
            } \
            if (VARIANT != 1) { \
            float mt = max3f(p0[0], p1[0], p0[1]), mu = max3f(p1[1], p0[2], p1[2]); \
            _Pragma("unroll") \
            for (int r = 3; r < 15; r += 2) { mt = max3f(mt, p0[r], p1[r]); mu = max3f(mu, p0[r + 1], p1[r + 1]); } \
            mt = pmax(max3f(mt, mu, fmaxf(p0[15], p1[15]))); \
            if (__any(t == 0 || mt > 8.0f)) { \
                const float dl = (t == 0) ? mt : fmaxf(mt, 0.f), sc = __builtin_amdgcn_exp2f(-dl); \
                mrun += dl; lsum *= sc; \
            _Pragma("unroll") \
                for (int r = 0; r < 16; ++r) { p0[r] -= dl; p1[r] -= dl; negm[r] = -mrun; } \
            _Pragma("unroll") \
                for (int dt = 0; dt < NDT; ++dt) \
            _Pragma("unroll") \
                    for (int r = 0; r < 16; ++r) o[dt][r] *= sc; \
            } \
            float ps0 = 0.f, ps1 = 0.f; \
            _Pragma("unroll") \
            for (int r = 0; r < 16; ++r) { p0[r] = __builtin_amdgcn_exp2f(p0[r]); p1[r] = __builtin_amdgcn_exp2f(p1[r]); ps0 += p0[r]; ps1 += p1[r]; } \
            lsum += ps0 + ps1; } \
            bf16x8 pf[4]; \
            { v4u w; \
              w.x = cvt_pk_bf16(p0[0], p0[1]); w.y = cvt_pk_bf16(p0[2], p0[3]); w.z = cvt_pk_bf16(p0[4], p0[5]); w.w = cvt_pk_bf16(p0[6], p0[7]); pf[0] = __builtin_bit_cast(bf16x8, w); \
              w.x = cvt_pk_bf16(p0[8], p0[9]); w.y = cvt_pk_bf16(p0[10], p0[11]); w.z = cvt_pk_bf16(p0[12], p0[13]); w.w = cvt_pk_bf16(p0[14], p0[15]); pf[1] = __builtin_bit_cast(bf16x8, w); \
              w.x = cvt_pk_bf16(p1[0], p1[1]); w.y = cvt_pk_bf16(p1[2], p1[3]); w.z = cvt_pk_bf16(p1[4], p1[5]); w.w = cvt_pk_bf16(p1[6], p1[7]); pf[2] = __builtin_bit_cast(bf16x8, w); \
              w.x = cvt_pk_bf16(p1[8], p1[9]); w.y = cvt_pk_bf16(p1[10], p1[11]); w.z = cvt_pk_bf16(p1[12], p1[13]); w.w = cvt_pk_bf16(p1[14], p1[15]); pf[3] = __builtin_bit_cast(bf16x8, w); } \
            const LAS unsigned char* vb = lds + 2 * KBUF + b * VBUF + r32 * VST + hi * 16; \
            _Pragma("unroll") \
            for (int dt = 0; dt < NDT; ++dt) \
            _Pragma("unroll") \
                for (int s = 0; s < 4; ++s) { \
                    const bf16x8 vf = *(const LAS bf16x8*)(vb + dt * 32 * VST + s * 32); \
                    if (VARIANT != 2) o[dt] = __builtin_amdgcn_mfma_f32_32x32x16_bf16(vf, pf[s], o[dt], 0, 0, 0); else o[dt][s] += __builtin_bit_cast(float, (int)vf[0]) + __builtin_bit_cast(float, (int)pf[s][0]); \
                } \
        } \
        if (VARIANT != 3 && (t) + 1 < NT) ATF_STORE(SK, SV, b ^ 1); \
        __syncthreads(); } while (0)
    for (int t = 0; t < NT; t += 2) {
        ATF_ITER(t, kregA, vregA, kregB, vregB);
        const int t1 = t + 1;
        if (t1 < NT) ATF_ITER(t1, kregB, vregB, kregA, vregA);
    }
#undef ATF_ITER
    const float lt = psum(lsum), inv = 1.0f / lt;
    bf16* orow = Op + (size_t)(32 * wid + r32) * op + 4 * hi;
#pragma unroll
    for (int dt = 0; dt < NDT; ++dt)
#pragma unroll
        for (int g = 0; g < 4; ++g) { v2u w; w.x = cvt_pk_bf16(o[dt][4 * g] * inv, o[dt][4 * g + 1] * inv); w.y = cvt_pk_bf16(o[dt][4 * g + 2] * inv, o[dt][4 * g + 3] * inv);
            *(v2u*)(orow + 32 * dt + 8 * g) = w; }
#undef ATF_LOAD
#undef ATF_STORE
}

template <int DQK, int DV, bool O8 = false>
__device__ __forceinline__ void unit_g(LAS unsigned char* lds, const int wave_in, const bf16* Qp, int qp, const bf16* Kp, int kp, const bf16* Krp, int krp, const bf16* Vp, int vp, bf16* Op, int op, int q0, int NT) {
    constexpr int KST = DQK * 2 + 16, VST = 144, KBUF = 64 * KST, VBUF = DV * VST;
    constexpr int NCK = DQK / 8, TOTV = DV * 8, NVI = (TOTV + 511) / 512, ND0 = DQK / 16, NDT = DV / 32;
    static_assert(NCK > 8 && NCK <= 16, "unit_g: K rows of 9..16 chunks");
    const int wid = wave_in, lane = lane_id(), tid = wid * 64 + lane, r32 = lane & 31, hi = lane >> 5;
    const int krow = tid >> 3, kj = tid & 7; const bool kval1 = kj + 8 < NCK;
    const int rho = (krow & ~12) | ((krow & 4) << 1) | ((krow & 8) >> 1);
    const bf16* ksrc0 = Kp + (size_t)krow * kp + 8 * kj; const bf16* ksrc1 = Krp + (size_t)krow * krp + 8 * kj; const int kdst0 = rho * KST + 16 * kj;
    const bf16* vsrc[NVI]; int vdst[NVI];
#pragma unroll
    for (int i = 0; i < NVI; ++i) { const int id = tid + 512 * i, d = id >> 3, j = id & 7; vsrc[i] = Vp + (size_t)d * vp + 8 * j; vdst[i] = d * VST + 16 * j; }
    v4u kreg[2], vreg[NVI];
#define ATG_LOAD(t) do { kreg[0] = *(const v4u*)(ksrc0 + (size_t)(t) * 64 * kp); kreg[1] = kval1 ? *(const v4u*)(ksrc1 + (size_t)(t) * 64 * krp) : (v4u){0u, 0u, 0u, 0u}; \
                         _Pragma("unroll") for (int i = 0; i < NVI; ++i) vreg[i] = *(const v4u*)(vsrc[i] + (size_t)(t) * 64); } while (0)
#define ATG_STORE(b) do { *(LAS v4u*)(lds + (b) * KBUF + kdst0) = kreg[0]; if (kval1) *(LAS v4u*)(lds + (b) * KBUF + kdst0 + 128) = kreg[1]; \
                          _Pragma("unroll") for (int i = 0; i < NVI; ++i) *(LAS v4u*)(lds + 2 * KBUF + (b) * VBUF + vdst[i]) = vreg[i]; } while (0)
    ATG_LOAD(0);
    bf16x8 qa[ND0], qb[ND0];
    { const bf16* qrow = Qp + (size_t)(64 * wid + r32) * qp + hi * 8;
#pragma unroll
      for (int d0 = 0; d0 < ND0; ++d0) { qa[d0] = *(const bf16x8*)(qrow + d0 * 16); qb[d0] = *(const bf16x8*)(qrow + (size_t)32 * qp + d0 * 16); } }
    ATG_STORE(0);
    __syncthreads();
    f32x16 oa[NDT], ob[NDT];
#pragma unroll
    for (int dt = 0; dt < NDT; ++dt)
#pragma unroll
        for (int r = 0; r < 16; ++r) { oa[dt][r] = 0.f; ob[dt][r] = 0.f; }
    float ma = 0.f, mb = 0.f, la = 0.f, lb = 0.f;
    const int tdiag = (q0 >> 6) + wid, qrel = r32;
#define ATG_SOFTMAX(P0, P1, M, L, O, PF) do { \
        float mt_ = max3f(P0[0], P1[0], P0[1]), mu_ = max3f(P1[1], P0[2], P1[2]); \
        _Pragma("unroll") for (int r = 3; r < 15; r += 2) { mt_ = max3f(mt_, P0[r], P1[r]); mu_ = max3f(mu_, P0[r + 1], P1[r + 1]); } \
        mt_ = pmax(max3f(mt_, mu_, fmaxf(P0[15], P1[15]))); \
        if (__any(t == 0 || mt_ > M + 8.0f)) { const float dl_ = (t == 0) ? mt_ - M : fmaxf(mt_ - M, 0.f), sc_ = __builtin_amdgcn_exp2f(-dl_); M += dl_; L *= sc_; \
            _Pragma("unroll") for (int dt = 0; dt < NDT; ++dt) _Pragma("unroll") for (int r = 0; r < 16; ++r) O[dt][r] *= sc_; } \
        float s0_ = 0.f, s1_ = 0.f; \
        _Pragma("unroll") for (int r = 0; r < 16; ++r) { P0[r] = __builtin_amdgcn_exp2f(P0[r] - M); P1[r] = __builtin_amdgcn_exp2f(P1[r] - M); s0_ += P0[r]; s1_ += P1[r]; } \
        L += s0_ + s1_; \
        { v4u w_; \
          w_.x = cvt_pk_bf16(P0[0], P0[1]); w_.y = cvt_pk_bf16(P0[2], P0[3]); w_.z = cvt_pk_bf16(P0[4], P0[5]); w_.w = cvt_pk_bf16(P0[6], P0[7]); PF[0] = __builtin_bit_cast(bf16x8, w_); \
          w_.x = cvt_pk_bf16(P0[8], P0[9]); w_.y = cvt_pk_bf16(P0[10], P0[11]); w_.z = cvt_pk_bf16(P0[12], P0[13]); w_.w = cvt_pk_bf16(P0[14], P0[15]); PF[1] = __builtin_bit_cast(bf16x8, w_); \
          w_.x = cvt_pk_bf16(P1[0], P1[1]); w_.y = cvt_pk_bf16(P1[2], P1[3]); w_.z = cvt_pk_bf16(P1[4], P1[5]); w_.w = cvt_pk_bf16(P1[6], P1[7]); PF[2] = __builtin_bit_cast(bf16x8, w_); \
          w_.x = cvt_pk_bf16(P1[8], P1[9]); w_.y = cvt_pk_bf16(P1[10], P1[11]); w_.z = cvt_pk_bf16(P1[12], P1[13]); w_.w = cvt_pk_bf16(P1[14], P1[15]); PF[3] = __builtin_bit_cast(bf16x8, w_); } } while (0)
    for (int t = 0; t < NT; ++t) {
        const int b = t & 1;
        if (t + 1 < NT) ATG_LOAD(t + 1);
        if (t <= tdiag) {
            const LAS unsigned char* kb = lds + b * KBUF + r32 * KST + hi * 16;
            f32x16 pa0, pa1, pb0, pb1;
#pragma unroll
            for (int r = 0; r < 16; ++r) { pa0[r] = 0.f; pa1[r] = 0.f; pb0[r] = 0.f; pb1[r] = 0.f; }
#pragma unroll
            for (int d0 = 0; d0 < ND0; ++d0) {
                const bf16x8 a0 = *(const LAS bf16x8*)(kb + d0 * 32), a1 = *(const LAS bf16x8*)(kb + 32 * KST + d0 * 32);
                pa0 = __builtin_amdgcn_mfma_f32_32x32x16_bf16(a0, qa[d0], pa0, 0, 0, 0); pa1 = __builtin_amdgcn_mfma_f32_32x32x16_bf16(a1, qa[d0], pa1, 0, 0, 0);
                pb0 = __builtin_amdgcn_mfma_f32_32x32x16_bf16(a0, qb[d0], pb0, 0, 0, 0); pb1 = __builtin_amdgcn_mfma_f32_32x32x16_bf16(a1, qb[d0], pb1, 0, 0, 0);
            }
            asm volatile("s_nop 15\n\ts_nop 7" : "+v"(pa0), "+v"(pa1), "+v"(pb0), "+v"(pb1));
            if (t == tdiag) {
#pragma unroll
                for (int r = 0; r < 16; ++r) { const int kk = 16 * (r >> 3) + 8 * hi + (r & 7);
                    if (kk > qrel) pa0[r] = -INFINITY; pa1[r] = -INFINITY; if (kk > qrel) pb1[r] = -INFINITY; }
            }
            bf16x8 pfa[4], pfb[4];
            ATG_SOFTMAX(pa0, pa1, ma, la, oa, pfa);
            ATG_SOFTMAX(pb0, pb1, mb, lb, ob, pfb);
            const LAS unsigned char* vb = lds + 2 * KBUF + b * VBUF + r32 * VST + hi * 16;
#pragma unroll
            for (int dt = 0; dt < NDT; ++dt)
#pragma unroll
                for (int s = 0; s < 4; ++s) {
                    const bf16x8 vf = *(const LAS bf16x8*)(vb + dt * 32 * VST + s * 32);
                    oa[dt] = __builtin_amdgcn_mfma_f32_32x32x16_bf16(vf, pfa[s], oa[dt], 0, 0, 0);
                    ob[dt] = __builtin_amdgcn_mfma_f32_32x32x16_bf16(vf, pfb[s], ob[dt], 0, 0, 0);
                }
        }
        if (t + 1 < NT) ATG_STORE(b ^ 1);
        __syncthreads();
    }
    const float ia = 1.0f / psum(la), ib = 1.0f / psum(lb);
    const int lane_e = lane_id();
    if constexpr (O8) {
        unsigned char* orow8 = (unsigned char*)Op + (size_t)(64 * wid + (lane_e & 31)) * op + 4 * (lane_e >> 5); const float ia8 = ia * Y8_SCALE, ib8 = ib * Y8_SCALE;
#pragma unroll
        for (int dt = 0; dt < NDT; ++dt)
#pragma unroll
            for (int g = 0; g < 4; ++g) {
                *(unsigned*)(orow8 + 32 * dt + 8 * g) = pk4_fp8(sat8(oa[dt][4 * g] * ia8), sat8(oa[dt][4 * g + 1] * ia8), sat8(oa[dt][4 * g + 2] * ia8), sat8(oa[dt][4 * g + 3] * ia8));
                *(unsigned*)(orow8 + (size_t)32 * op + 32 * dt + 8 * g) = pk4_fp8(sat8(ob[dt][4 * g] * ib8), sat8(ob[dt][4 * g + 1] * ib8), sat8(ob[dt][4 * g + 2] * ib8), sat8(ob[dt][4 * g + 3] * ib8)); }
    } else {
    bf16* orow = Op + (size_t)(64 * wid + (lane_e & 31)) * op + 4 * (lane_e >> 5);
#pragma unroll
    for (int dt = 0; dt < NDT; ++dt)
#pragma unroll
        for (int g = 0; g < 4; ++g) { v2u w; w.x = cvt_pk_bf16(oa[dt][4 * g] * ia, oa[dt][4 * g + 1] * ia); w.y = cvt_pk_bf16(oa[dt][4 * g + 2] * ia, oa[dt][4 * g + 3] * ia);
            *(v2u*)(orow + 32 * dt + 8 * g) = w;
            w.x = cvt_pk_bf16(ob[dt][4 * g] * ib, ob[dt][4 * g + 1] * ib); w.y = cvt_pk_bf16(ob[dt][4 * g + 2] * ib, ob[dt][4 * g + 3] * ib);
            *(v2u*)(orow + (size_t)32 * op + 32 * dt + 8 * g) = w; }
    }
#undef ATG_LOAD
#undef ATG_STORE
#undef ATG_SOFTMAX
}
}

#define XB_TMO      128
#define XB_XCNT(j)  (256  + 64 * (j))
#define XB_XSUB(j)  (1280 + 64 * (j))
#define XB_XGEN(j)  (2304 + 64 * (j))
#define XB_TOP      3328
#define XB_TOPGEN   3392
#define XCD_BAR_WORDS 3456
#define XB_SPIN_CAP (1u << 18)
__device__ __forceinline__ unsigned xb_ld(unsigned* p)              { return __hip_atomic_load(p, __ATOMIC_RELAXED, __HIP_MEMORY_SCOPE_AGENT); }
__device__ __forceinline__ unsigned xb_add(unsigned* p, unsigned v) { return __hip_atomic_fetch_add(p, v, __ATOMIC_RELAXED, __HIP_MEMORY_SCOPE_AGENT); }
__device__ __forceinline__ unsigned xb_xcc_id() { return (unsigned)__builtin_amdgcn_s_getreg((3 << 11) | 20) & 0xFu; }
#define XB_SPIN(cond, bar) do { unsigned _sp = 0; while (cond) { __builtin_amdgcn_s_sleep(1); \
    if ((++_sp & 255u) == 0u) { if (xb_ld(&(bar)[XB_TMO])) break; if (_sp > XB_SPIN_CAP) { atomicAdd(&(bar)[XB_TMO], 1u); break; } } } } while (0)
struct XcdBarrier { unsigned* bar; unsigned x; volatile LAS unsigned* st; int wave; };
__device__ __forceinline__ XcdBarrier xcd_barrier_post(unsigned* bar, volatile LAS unsigned* st, int wave) {
    XcdBarrier b; b.bar = bar; b.x = xb_xcc_id(); b.st = st; b.wave = wave;
    if (wave == 0 && lane_id() == 0) (void)xb_add(&bar[XB_XCNT(b.x)], 1u);
    return b;
}
__device__ __forceinline__ void xcd_barrier_complete(unsigned* bar, unsigned x, unsigned& nloc, unsigned& nx) {
    const unsigned G = gridDim.x * gridDim.y * gridDim.z;
    unsigned sum, cnt, mine, sp = 0u;
    for (;;) {
        sum = 0u; cnt = 0u; mine = 0u;
#pragma unroll
        for (unsigned j = 0; j < 16; ++j) { const unsigned c = xb_ld(&bar[XB_XCNT(j)]); sum += c; cnt += (c > 0u) ? 1u : 0u; mine = (j == x) ? c : mine; }
        if (sum == G) break;
        __builtin_amdgcn_s_sleep(1);
        if ((++sp & 255u) == 0u) { if (xb_ld(&bar[XB_TMO])) break; if (sp > XB_SPIN_CAP) { atomicAdd(&bar[XB_TMO], 1u); break; } }
    }
    nloc = mine > 0u ? mine : 1u; nx = cnt > 0u ? cnt : 1u;
}
__device__ __forceinline__ void xcd_barrier(const XcdBarrier& b) {
    asm volatile("s_waitcnt vmcnt(0)" ::: "memory");
    __syncthreads();
    if (b.wave == 0 && lane_id() == 0) {
        unsigned* bar = b.bar;
        __builtin_amdgcn_s_waitcnt(0);
        unsigned nloc = b.st[0], nx = b.st[1];
        if (nloc == 0u) { xcd_barrier_complete(bar, b.x, nloc, nx); b.st[0] = nloc; b.st[1] = nx; }
        const unsigned old = xb_add(&bar[XB_XSUB(b.x)], 1u);
        const unsigned gen = old / nloc;
        if (old + 1u == (gen + 1u) * nloc) {
            __builtin_amdgcn_fence(__ATOMIC_RELEASE, "agent");
            asm volatile("s_waitcnt vmcnt(0)" ::: "memory");
            const unsigned og = xb_add(&bar[XB_TOP], 1u);
            const unsigned tg = og / nx;
            if (og + 1u == (tg + 1u) * nx) xb_add(&bar[XB_TOPGEN], 1u);
            else XB_SPIN(xb_ld(&bar[XB_TOPGEN]) == tg, bar);
            __builtin_amdgcn_fence(__ATOMIC_ACQUIRE, "agent");
            xb_add(&bar[XB_XGEN(b.x)], 1u);
            asm volatile("s_waitcnt vmcnt(0)" ::: "memory");
        } else {
            XB_SPIN(xb_ld(&bar[XB_XGEN(b.x)]) == gen, bar);
            __builtin_amdgcn_fence(__ATOMIC_ACQUIRE, "agent");
            asm volatile("s_waitcnt vmcnt(0)" ::: "memory");
        }
    }
    __syncthreads();
}

struct Args { const void* in[29]; float* out; unsigned char* ws; int ph_lo, ph_hi; };
struct Frame {
    LAS unsigned char* lds; int wave, vcu, G;
    __device__ __forceinline__ int lane() const { return lane_id(); }
    __device__ __forceinline__ int tid() const { return wave * 64 + lane_id(); }
};
typedef const __attribute__((address_space(4))) Args* KA;
__device__ __forceinline__ KA kargs() { KA p = (KA)__builtin_amdgcn_kernarg_segment_ptr(); asm volatile("" : "+s"(p)); return p; }

template <class RowFn>
__device__ __forceinline__ void p0_transpose_item(const float* W, int N, const float* gk, int item, LAS float* scr, int lane, RowFn rowfn, unsigned char* w8 = nullptr, int n8lo = 0, float s8 = 1.f, bool all8 = false) {
    const int nblk = N / 32, kb = item / nblk, nb = item % nblk, k0 = 64 * kb, n0 = 32 * nb;
    f32x4 ld[8];
#pragma unroll
    for (int i = 0; i < 8; ++i) ld[i] = *(const f32x4*)(W + (size_t)(k0 + 8 * i + (lane >> 3)) * N + n0 + 4 * (lane & 7));
#pragma unroll
    for (int i = 0; i < 8; ++i) { const int kk = 8 * i + (lane >> 3); f32x4 v = ld[i]; if (gk) v = v * gk[k0 + kk];
        LAS float* d = scr + kk * 33 + 4 * (lane & 7); d[0] = v.x; d[1] = v.y; d[2] = v.z; d[3] = v.w; }
    LDS_WAIT(); asm volatile("" ::: "memory");
    const int c = lane & 7;
#pragma unroll
    for (int j = 0; j < 4; ++j) { const int n = (lane >> 3) + 8 * j; const LAS float* s = scr + (8 * c) * 33 + n;
        if (all8) { v2u o8; o8.x = pk4_fp8(s[0 * 33] * s8, s[1 * 33] * s8, s[2 * 33] * s8, s[3 * 33] * s8); o8.y = pk4_fp8(s[4 * 33] * s8, s[5 * 33] * s8, s[6 * 33] * s8, s[7 * 33] * s8);
            *(v2u*)((unsigned char*)rowfn(n0 + n) + k0 + 8 * c) = o8; continue; }
        if (w8 && n0 + n >= n8lo) { v2u o8; o8.x = pk4_fp8(s[0 * 33] * s8, s[1 * 33] * s8, s[2 * 33] * s8, s[3 * 33] * s8); o8.y = pk4_fp8(s[4 * 33] * s8, s[5 * 33] * s8, s[6 * 33] * s8, s[7 * 33] * s8);
            *(v2u*)((unsigned char*)rowfn(n0 + n) + k0 + 8 * c) = o8; continue; }
        v4u o; o.x = cvt_pk_bf16(s[0 * 33], s[1 * 33]); o.y = cvt_pk_bf16(s[2 * 33], s[3 * 33]); o.z = cvt_pk_bf16(s[4 * 33], s[5 * 33]); o.w = cvt_pk_bf16(s[6 * 33], s[7 * 33]);
        bf16* rp = rowfn(n0 + n); if (rp) *(v4u*)(rp + k0 + 8 * c) = o; }
    LDS_WAIT(); asm volatile("" ::: "memory");
}

template <class RowFn>
__device__ __forceinline__ void p0_transpose_item64(const float* W, int N, const float* gk, int item, LAS float* scr, int lane, RowFn rowfn, float s8, bool all8) {
    const int nblk = N / 64, kb = item / nblk, nb = item % nblk, k0 = 64 * kb, n0 = 64 * nb;
    f32x4 ld[16];
#pragma unroll
    for (int i = 0; i < 16; ++i) ld[i] = *(const f32x4*)(W + (size_t)(k0 + 4 * i + (lane >> 4)) * N + n0 + 4 * (lane & 15));
#pragma unroll
    for (int i = 0; i < 16; ++i) { const int kk = 4 * i + (lane >> 4), nn = 4 * (lane & 15); f32x4 v = ld[i]; if (gk) v = v * gk[k0 + kk];
        LAS float* d = scr + kk * 64; d[(nn + kk) & 63] = v.x; d[(nn + 1 + kk) & 63] = v.y; d[(nn + 2 + kk) & 63] = v.z; d[(nn + 3 + kk) & 63] = v.w; }
    LDS_WAIT(); asm volatile("" ::: "memory");
    const int c = lane & 7;
#pragma unroll
    for (int j = 0; j < 8; ++j) { const int n = (lane >> 3) + 8 * j; float e[8];
#pragma unroll
        for (int i = 0; i < 8; ++i) { const int kk = 8 * c + i; e[i] = scr[kk * 64 + ((n + kk) & 63)]; }
        if (all8) { v2u o8; o8.x = pk4_fp8(e[0] * s8, e[1] * s8, e[2] * s8, e[3] * s8); o8.y = pk4_fp8(e[4] * s8, e[5] * s8, e[6] * s8, e[7] * s8);
            *(v2u*)((unsigned char*)rowfn(n0 + n) + k0 + 8 * c) = o8; }
        else { v4u o; o.x = cvt_pk_bf16(e[0], e[1]); o.y = cvt_pk_bf16(e[2], e[3]); o.z = cvt_pk_bf16(e[4], e[5]); o.w = cvt_pk_bf16(e[6], e[7]); *(v4u*)(rowfn(n0 + n) + k0 + 8 * c) = o; } }
    LDS_WAIT(); asm volatile("" ::: "memory");
}
__device__ __forceinline__ void rms_row_to_bf16(const float* xrow, const float* gain, bf16* orow, int lane, unsigned char* f8row = nullptr) {
    const f32x4* xr = (const f32x4*)xrow + lane; const f32x4* gr = (const f32x4*)gain + lane;
    f32x4 v[4]; float s = 0.f;
#pragma unroll
    for (int j = 0; j < 4; ++j) { v[j] = xr[64 * j]; s += (v[j].x * v[j].x + v[j].y * v[j].y) + (v[j].z * v[j].z + v[j].w * v[j].w); }
    const float rs = rsqrtf(wave_sum(s) * (1.f / 1024.f) + EPS);
    unsigned long long* o8 = (unsigned long long*)orow + lane;
#pragma unroll
    for (int j = 0; j < 4; ++j) { const f32x4 g = gr[64 * j]; const float a = v[j].x * rs * g.x, b = v[j].y * rs * g.y, c = v[j].z * rs * g.z, d = v[j].w * rs * g.w;
        o8[64 * j] = (unsigned long long)cvt_pk_bf16(a, b) | ((unsigned long long)cvt_pk_bf16(c, d) << 32);
        if (f8row) ((unsigned*)f8row)[lane + 64 * j] = pk4_fp8(a, b, c, d); }
}

__device__ __forceinline__ void rms_row2_to_bf16(const float* xa, const float* xb, const float* gain, bf16* oa, bf16* ob, unsigned char* f8a, unsigned char* f8b, int lane) {
    const f32x4* ra = (const f32x4*)xa + lane; const f32x4* rb = (const f32x4*)xb + lane; const f32x4* gr = (const f32x4*)gain + lane;
    f32x4 va[4], vb[4]; float sa = 0.f, sb = 0.f;
#pragma unroll
    for (int j = 0; j < 4; ++j) { va[j] = ra[64 * j]; vb[j] = rb[64 * j]; }
#pragma unroll
    for (int j = 0; j < 4; ++j) { sa += (va[j].x * va[j].x + va[j].y * va[j].y) + (va[j].z * va[j].z + va[j].w * va[j].w); sb += (vb[j].x * vb[j].x + vb[j].y * vb[j].y) + (vb[j].z * vb[j].z + vb[j].w * vb[j].w); }
    const float rsa = rsqrtf(wave_sum(sa) * (1.f / 1024.f) + EPS), rsb = rsqrtf(wave_sum(sb) * (1.f / 1024.f) + EPS);
    unsigned long long* pa = (unsigned long long*)oa + lane; unsigned long long* pb = (unsigned long long*)ob + lane;
#pragma unroll
    for (int j = 0; j < 4; ++j) { const f32x4 g = gr[64 * j]; const f32x4 ya = va[j] * rsa * g, yb = vb[j] * rsb * g;
        pa[64 * j] = (unsigned long long)cvt_pk_bf16(ya.x, ya.y) | ((unsigned long long)cvt_pk_bf16(ya.z, ya.w) << 32);
        pb[64 * j] = (unsigned long long)cvt_pk_bf16(yb.x, yb.y) | ((unsigned long long)cvt_pk_bf16(yb.z, yb.w) << 32);
        ((unsigned*)f8a)[lane + 64 * j] = pk4_fp8(ya.x, ya.y, ya.z, ya.w); ((unsigned*)f8b)[lane + 64 * j] = pk4_fp8(yb.x, yb.y, yb.z, yb.w); }
}

__device__ __forceinline__ void p0_prologue(const Frame& F) {
    const KA ka = kargs(); unsigned char* ws = ka->ws;
    const float* x = (const float*)ka->in[0]; const float* mem = (const float*)ka->in[1]; const int* pos = (const int*)ka->in[2];
    const float* g_mix = (const float*)ka->in[3]; const float* w_in = (const float*)ka->in[4];
    const float* lru_wa = (const float*)ka->in[7]; const float* lru_wx = (const float*)ka->in[9];
    const float* g_q = (const float*)ka->in[12]; const float* w_uq = (const float*)ka->in[13]; const float* g_kv = (const float*)ka->in[14]; const float* w_ukv = (const float*)ka->in[15];
    const float* g_mem = (const float*)ka->in[16]; const float* w_mem_kv = (const float*)ka->in[17]; const float* w_branch = (const float*)ka->in[18]; const float* w_o = (const float*)ka->in[19];
    const float* g_ffn = (const float*)ka->in[20]; const float* w_group = (const float*)ka->in[21]; const float* w_router = (const float*)ka->in[23];
    const float* w_e_gate = (const float*)ka->in[25]; const float* w_e_up = (const float*)ka->in[26]; const float* w_e_down = (const float*)ka->in[27];
    bf16* WIN = (bf16*)(ws + WS_WIN); bf16* WUQ = (bf16*)(ws + WS_WUQ); bf16* WK = (bf16*)(ws + WS_WK); bf16* WV = (bf16*)(ws + WS_WV);
    bf16* WMK = (bf16*)(ws + WS_WMK); bf16* WMV = (bf16*)(ws + WS_WMV); bf16* WBR = (bf16*)(ws + WS_WBR); bf16* WO = (bf16*)(ws + WS_WO);
    bf16* WR = (bf16*)(ws + WS_WR); bf16* WLRU = (bf16*)(ws + WS_WLRU); bf16* W1 = (bf16*)(ws + WS_W1); bf16* W2 = (bf16*)(ws + WS_W2);
    LAS float* scr = (LAS float*)(F.lds + F.wave * 16384);
    const int lane = F.lane();
    const int gw = F.vcu * NWAVES + F.wave, NGW = F.G * NWAVES;
    constexpr int I_IN = 16 * 157, I_UQ = 4 * 24, I_UKV = 2 * 32, I_MKV = 16 * 32, I_BR = 3 * 8 * 32, I_O = 16 * 32, I_EG = 16 * 4, I_ED = 4 * 16, I_EXP = 2 * I_EG + I_ED;
    constexpr int NITEMS = I_IN + I_UQ + I_UKV + I_MKV + I_BR + I_O + NEXP * I_EXP;
    for (int it = gw; it < NITEMS; it += NGW) {
        int r = it;
        if (r < I_IN) { p0_transpose_item(w_in, 5024, nullptr, r, scr, lane, [&](int n) -> bf16* {
                int d; if (n < 1408) d = n; else if (n < 1440) { const int j = n - 1408; d = 1408 + 2 * (j & 15) + (j >> 4); } else d = n + 96;
                return d < 1024 ? WIN + (size_t)d * 1024 : (bf16*)(ws + WS_WG8 + (size_t)(d - 1024) * 1024); }, ws + WS_WG8, 1024, WG8_SCALE); continue; } r -= I_IN;
        if (r < I_UQ) { p0_transpose_item(w_uq, 768, g_q, r, scr, lane, [&](int n) -> bf16* {
                const int h = n / 96, d = n % 96; int dd = d; if (d >= 64) { const int j = d - 64; dd = 64 + 2 * (j & 15) + (j >> 4); }
                return (bf16*)((unsigned char*)WUQ + (size_t)(h * 96 + dd) * 256); }, nullptr, 0, WU8_SCALE, true); continue; } r -= I_UQ;
        if (r < I_UKV) { p0_transpose_item(w_ukv, 1024, g_kv, r, scr, lane, [&](int n) -> bf16* {
                const int h = n >> 7, dd = n & 127; return (bf16*)(dd < 64 ? (unsigned char*)WK + (size_t)(h * 64 + dd) * 256 : (unsigned char*)WV + (size_t)(h * 64 + dd - 64) * 256); }, nullptr, 0, WU8_SCALE, true); continue; } r -= I_UKV;
        if (r < I_MKV) { p0_transpose_item(w_mem_kv, 1024, nullptr, r, scr, lane, [&](int n) -> bf16* {
                return n < 512 ? WMK + (size_t)n * 1024 : WMV + (size_t)(n - 512) * 1024; }); continue; } r -= I_MKV;
        if (r < I_BR) { const int b = r / (8 * 32), rr = r % (8 * 32); p0_transpose_item(w_branch + (size_t)b * 512 * 1024, 1024, nullptr, rr, scr, lane, [&](int n) -> bf16* {
                return WBR + ((size_t)b * 1024 + n) * 512; }, nullptr, 0, b ? WB8_SCALE : 1.f, b != 0); continue; } r -= I_BR;
        if (r < I_O) { p0_transpose_item(w_o, 1024, nullptr, r, scr, lane, [&](int n) -> bf16* { return WO + (size_t)n * 1024; }); continue; } r -= I_O;
        { const int e = r / I_EXP; int q = r % I_EXP;
          unsigned char* const W18 = (unsigned char*)W1;
          if (q < I_EG) { p0_transpose_item64(w_e_gate + (size_t)e * 1024 * 256, 256, g_ffn, q, scr, lane, [&](int n) -> bf16* {
                  return (bf16*)(W18 + ((size_t)e * 512 + (n >> 7) * 256 + (n & 127)) * 1024); }, W18_SCALE, true); continue; } q -= I_EG;
          if (q < I_EG) { p0_transpose_item64(w_e_up + (size_t)e * 1024 * 256, 256, g_ffn, q, scr, lane, [&](int n) -> bf16* {
                  return (bf16*)(W18 + ((size_t)e * 512 + (n >> 7) * 256 + 128 + (n & 127)) * 1024); }, W18_SCALE, true); continue; } q -= I_EG;
          p0_transpose_item64(w_e_down + (size_t)e * 256 * 1024, 1024, nullptr, q, scr, lane, [&](int n) -> bf16* { return (bf16*)((unsigned char*)W2 + ((size_t)e * 1024 + n) * 256); }, W28_SCALE, true); }
    }
    const int gt = F.vcu * (NWAVES * 64) + F.wave * 64 + lane, NGT = F.G * NWAVES * 64;
    for (int i = gt; i < 96 * 1024 / 16; i += NGT) *(v4u*)(ws + WS_WG8 + (size_t)(1440 - 1024) * 1024 + (size_t)i * 16) = (v4u){0u, 0u, 0u, 0u};
    for (int i = gt; i < 2 * 512 * 8; i += NGT) { const int mat = i >> 12, r = (i >> 3) & 511, ch = i & 7; *(v4u*)((unsigned char*)(mat ? WV : WK) + (size_t)r * 256 + 128 + ch * 16) = (v4u){0u, 0u, 0u, 0u}; }
    for (int i = gt; i < 256 * 1024; i += NGT) { const int r = i >> 10, k = i & 1023; float v = 0.f;
        if (r < 32) v = w_router[k * 32 + r] * g_ffn[k]; else if (r >= 128 && r < 132) v = w_group[k * 4 + (r - 128)] * g_ffn[k];
        WR[i] = f2bf(v); }
    for (int i = gt; i < 2 * 8 * 64 * 64; i += NGT) { const int mat = i >> 15, n = (i >> 12) & 7, d = (i >> 6) & 63, c = i & 63;
        const float* src = mat ? lru_wx : lru_wa; WLRU[i] = f2bf(src[(n * 64 + c) * 64 + d]); }
    { float* cosT = (float*)(ws + WS_COS); float* sinT = (float*)(ws + WS_SIN);
      for (int i = gt; i < T * 16; i += NGT) { const int t = i >> 4, f = i & 15;
          const double c4[4] = {1.0, 0.5623413251903491, 0.31622776601683794, 0.1778279410038923};
          double inv = (f & 3) == 0 ? c4[0] : ((f & 3) == 1 ? c4[1] : ((f & 3) == 2 ? c4[2] : c4[3]));
          const int dec = f >> 2; inv *= dec == 0 ? 1.0 : (dec == 1 ? 0.1 : (dec == 2 ? 0.01 : 0.001));
          const double rev = (double)pos[t] * inv * 0.15915494309189535; const float fr = (float)(rev - __builtin_rint(rev));
          cosT[i] = __builtin_amdgcn_cosf(fr); sinT[i] = __builtin_amdgcn_sinf(fr); } }
    bf16* XN = (bf16*)(ws + WS_XN); bf16* MEMN = (bf16*)(ws + WS_MEMN);
    unsigned char* XN8 = (unsigned char*)ka->out + DO_XN8;
    if (T % (2 * NGW) != 0) { for (int m = gw; m < T; m += NGW) rms_row_to_bf16(x + (size_t)m * DM, g_mix, XN + (size_t)m * DM, lane, XN8 + (size_t)m * DM); }
    else for (int m = gw; m < T; m += 2 * NGW) rms_row2_to_bf16(x + (size_t)m * DM, x + (size_t)(m + NGW) * DM, g_mix, XN + (size_t)m * DM, XN + (size_t)(m + NGW) * DM, XN8 + (size_t)m * DM, XN8 + (size_t)(m + NGW) * DM, lane);
    for (int m = gw; m < MROWS; m += NGW) rms_row_to_bf16(mem + (size_t)m * DM, g_mem, MEMN + (size_t)m * DM, lane);
}

template <int PASS>
__device__ __forceinline__ void lru_unit(const Frame& F, int b, int seg) {
    const KA ka = kargs(); unsigned char* ws = ka->ws;
    const float* conv_w = (const float*)ka->in[5]; const float* conv_b = (const float*)ka->in[6]; const float* lru_ba = (const float*)ka->in[8]; const float* lru_bx = (const float*)ka->in[10];
    const float* lam = (const float*)ka->in[11];
    const bf16* XL = (const bf16*)(ws + WS_XL); bf16* GL = (bf16*)(ws + WS_GL); const bf16* WLRU = (const bf16*)(ws + WS_WLRU); float* LSUM = (float*)(ws + WS_LSUM);
    constexpr int XAST = 1040, GST = 2064, XA_OFF = 0, GA_OFF = 16 * XAST, GX_OFF = GA_OFF + 16 * GST;
    const int n = F.wave, lane = lane_id(), c = n * 64 + lane, fr = lane & 15, fq = lane >> 4;
    const float cw0 = conv_w[c], cw1 = conv_w[512 + c], cw2 = conv_w[1024 + c], cw3 = conv_w[1536 + c], cb = conv_b[c], ba = lru_ba[c], bx = lru_bx[c];
    const float sp8 = -8.0f * log1pf(expf(-lam[c]));
    bf16x8 waf[4][2], wxf[4][2];
#pragma unroll
    for (int nt = 0; nt < 4; ++nt)
#pragma unroll
        for (int ks = 0; ks < 2; ++ks) { const size_t o = (size_t)(n * 64 + 16 * nt + fr) * 64 + 32 * ks + 8 * fq;
            waf[nt][ks] = *(const bf16x8*)(WLRU + o); wxf[nt][ks] = *(const bf16x8*)(WLRU + 32768 + o); }
    const size_t t0 = (size_t)b * SEQ + (size_t)seg * 128;
    float xm1 = 0.f, xm2 = 0.f, xm3 = 0.f;
    if (seg > 0) { xm1 = bf2f(XL[(t0 - 1) * 512 + c]); xm2 = bf2f(XL[(t0 - 2) * 512 + c]); xm3 = bf2f(XL[(t0 - 3) * 512 + c]); }
    float h = 0.f, ap = 1.f;
    if (PASS == 2) { const float* sb = LSUM + (size_t)b * 32 * 1024;
        for (int s = 0; s < seg; ++s) h = sb[s * 1024 + c] * h + sb[s * 1024 + 512 + c]; }
    LAS unsigned char* lds = F.lds;
    bf16 xr[16], gr[16];
#pragma unroll
    for (int tt = 0; tt < 16; ++tt) { xr[tt] = XL[(t0 + tt) * 512 + c]; gr[tt] = PASS == 2 ? GL[(t0 + tt) * 512 + c] : (bf16)0; }
    for (int sub = 0; sub < 8; ++sub) {
        const size_t ts = t0 + sub * 16;
        float xav[16], glv[16];
#pragma unroll
        for (int tt = 0; tt < 16; ++tt) { const float x0 = bf2f(xr[tt]);
            if (PASS == 2) glv[tt] = bf2f(gr[tt]);
            const float xa = cw3 * x0 + cw2 * xm1 + cw1 * xm2 + cw0 * xm3 + cb; xm3 = xm2; xm2 = xm1; xm1 = x0; xav[tt] = xa;
            *(LAS bf16*)(lds + XA_OFF + tt * XAST + c * 2) = f2bf(xa); }
        if (sub < 7) {
#pragma unroll
            for (int tt = 0; tt < 16; ++tt) { xr[tt] = XL[(ts + 16 + tt) * 512 + c]; if (PASS == 2) gr[tt] = GL[(ts + 16 + tt) * 512 + c]; }
        }
        { f32x4 aa[4], ax[4];
#pragma unroll
          for (int nt = 0; nt < 4; ++nt) { aa[nt] = (f32x4){0.f, 0.f, 0.f, 0.f}; ax[nt] = (f32x4){0.f, 0.f, 0.f, 0.f}; }
#pragma unroll
          for (int ks = 0; ks < 2; ++ks) { const bf16x8 xf = *(const LAS bf16x8*)(lds + XA_OFF + fr * XAST + (n * 64 + 32 * ks + 8 * fq) * 2);
#pragma unroll
              for (int nt = 0; nt < 4; ++nt) { aa[nt] = __builtin_amdgcn_mfma_f32_16x16x32_bf16(waf[nt][ks], xf, aa[nt], 0, 0, 0); ax[nt] = __builtin_amdgcn_mfma_f32_16x16x32_bf16(wxf[nt][ks], xf, ax[nt], 0, 0, 0); } }
#pragma unroll
          for (int nt = 0; nt < 4; ++nt) { *(LAS f32x4*)(lds + GA_OFF + fr * GST + (n * 64 + 16 * nt + 4 * fq) * 4) = aa[nt]; *(LAS f32x4*)(lds + GX_OFF + fr * GST + (n * 64 + 16 * nt + 4 * fq) * 4) = ax[nt]; } }
#pragma unroll
        for (int tt = 0; tt < 16; ++tt) {
            const float ga = *(const LAS float*)(lds + GA_OFF + tt * GST + c * 4) + ba, gx = *(const LAS float*)(lds + GX_OFF + tt * GST + c * 4) + bx;
            const float r = fast_sigmoid(ga), ig = fast_sigmoid(gx);
            const float la = sp8 * r, av = __builtin_amdgcn_exp2f(la * LOG2E);
            const float mult = __builtin_sqrtf(fmaxf(1.0f - av * av, 0.f));
            h = av * h + mult * ig * xav[tt];
            if (PASS == 1) ap *= av;
            if (PASS == 2) GL[(ts + tt) * 512 + c] = f2bf(h * glv[tt]);
        }
    }
    if (PASS == 1) { float* sb = LSUM + ((size_t)b * 32 + seg) * 1024; sb[c] = ap; sb[512 + c] = h; }
    __syncthreads();
}

__device__ __forceinline__ MoeTab moe_tables(const Frame& F, const unsigned* gcnt) {
    LAS int* p = (LAS int*)(F.lds + MOE_OFF);
    const int tid = F.tid();
    __syncthreads();
    if (tid < 32) p[tid] = (int)gcnt[tid];
    __syncthreads();
    if (tid == 0) { int base = 0, nt = 0;
        for (int e = 0; e < 32; ++e) { const int c = p[e], ntl = (c + 255) >> 8; p[32 + e] = base;
            for (int r = 0; r < ntl; ++r) { p[128 + nt] = e; p[128 + MAXTILES + nt] = r; ++nt; }
            base += ntl * 256; }
        p[64] = nt; }
    __syncthreads();
    MoeTab t; t.p = p; return t;
}

constexpr int NPHASE = 10;
__global__ void __launch_bounds__(NWAVES * 64, 2) fwd_kernel(Args args) {
    extern __shared__ __attribute__((aligned(16))) unsigned char lds_raw[];
    Frame F;
    F.lds = (LAS unsigned char*)lds_raw;
    F.wave = __builtin_amdgcn_readfirstlane((int)threadIdx.x >> 6);
    F.G = gridDim.x; { const int bx = blockIdx.x; F.vcu = (F.G % 8 == 0) ? (bx % 8) * (F.G / 8) + bx / 8 : bx; }
    const KA ka0 = kargs();
    unsigned* ctl0 = (unsigned*)(ka0->ws + WS_CTL);
    volatile LAS unsigned* MISC = (volatile LAS unsigned*)(F.lds + MISC_OFF);
    { const int t0_ = F.tid(); if (t0_ < 32) MISC[t0_] = 0u; }
    __syncthreads();
    XcdBarrier bar; bar.bar = ctl0 + CW_BAR; bar.x = 0; bar.st = nullptr; bar.wave = F.wave;
    if (!MK_SPLIT) bar = xcd_barrier_post(ctl0 + CW_BAR, MISC + 8, F.wave);
    const int lo = ka0->ph_lo, hi = ka0->ph_hi;
#ifndef PH_MASK
#define PH_MASK 0x3ff
#endif
#define IN(k) (((PH_MASK >> (k)) & 1) && lo <= (k) && (k) < hi)
#define GRID_BAR(k) do { if (!MK_SPLIT && IN((k) + 1)) xcd_barrier(bar); } while (0)

#define PHASE_PTRS const KA ka = kargs(); unsigned char* const ws = ka->ws; unsigned* const ctl = (unsigned*)(ws + WS_CTL); \
    float* const ssq_q = (float*)(ws + WS_SSQQ); float* const ssq_kv = (float*)(ws + WS_SSQKV); float* const ssq_h = (float*)(ws + WS_SSQH); unsigned* const gcnt = ctl + CW_CNT; \
    const float* const cosT = (const float*)(ws + WS_COS); const float* const sinT = (const float*)(ws + WS_SIN); unsigned char* const dob = (unsigned char*)ka->out; \
    bf16* const Qb = (bf16*)(dob + DO_Q); bf16* const Kb = (bf16*)(dob + DO_K); bf16* const Vtb = (bf16*)(dob + DO_VT); \
    (void)ssq_q; (void)ssq_kv; (void)ssq_h; (void)gcnt; (void)cosT; (void)sinT; (void)Qb; (void)Kb; (void)Vtb;

    if (IN(0)) { _Pragma("unroll") for (int rep = 0; rep < REPN(0); ++rep) p0_prologue(F); GRID_BAR(0); }

    if (IN(1)) { PHASE_PTRS
        _Pragma("unroll") for (int rep = 0; rep < REPN(1); ++rep) {
        const bool PSKIP = REPN(1) == 2 && rep == 0 && (PROBE_SKIP == 1 ? (F.vcu & 1) != 0 : PROBE_SKIP == 2 ? (F.vcu >> 5) < 4 : PROBE_SKIP >= 3);
        { const SchedGrid2 S = make_grid1(F.G, F.vcu, T / 256, 4, ws + WS_XN, ws + WS_WIN, 1024, 1024);
          const EpiProj E{(bf16*)(ws + WS_XL), (bf16*)(ws + WS_GL), (bf16*)(ws + WS_CQ), (bf16*)(ws + WS_CKV), (bf16*)(ws + WS_QM), (bf16*)(ws + WS_SG), (bf16*)(dob + DO_KR), ssq_q, ssq_kv, cosT, sinT, PSKIP, 0, 1.0f};
          pg8::gemm_phase<EpiProj, SchedGrid2, true, false>(F.lds, F.wave, 1024, 1024, 1024, S, E); }
        { const SchedGrid2 S = make_grid1(F.G, F.vcu, T / 256, 16, dob + DO_XN8, ws + WS_WG8, 512, 512);
          const EpiProj E{(bf16*)(ws + WS_XL), (bf16*)(ws + WS_GL), (bf16*)(ws + WS_CQ), (bf16*)(ws + WS_CKV), (bf16*)(ws + WS_QM), (bf16*)(ws + WS_SG), (bf16*)(dob + DO_KR), ssq_q, ssq_kv, cosT, sinT, PSKIP, 4, GATE_UNSCALE};
          pg8::gemm_phase<EpiProj, SchedGrid2, true, false, true>(F.lds, F.wave, 512, 512, 512, S, E); }
        }
        GRID_BAR(1);
    }

    if (IN(2)) { PHASE_PTRS
#ifndef SUBM
#define SUBM 0xff
#endif
        _Pragma("unroll") for (int rep = 0; rep < REPN(2); ++rep) {
        const bool deal = (F.G == 256); const int ce = F.vcu < 128 ? F.vcu : F.vcu - 32, Gq = deal ? 224 : F.G;
        const int cq = !deal ? F.vcu : ((F.vcu >= 128 && F.vcu < 160) ? (1 << 20) : ce), ck = !deal ? F.vcu : ((F.vcu >= 128 && F.vcu < 160) ? (1 << 20) : 223 - ce);
        if (SUBM & 1) { const SchedGrid2 S = make_grid1(Gq, cq, T / 256, 3, ws + WS_CQ, ws + WS_WUQ, 128, 128);
          const EpiQ E{Qb, ssq_q, cosT, sinT};
          pg8::gemm_phase<EpiQ, SchedGrid2, true, false, true>(F.lds, F.wave, 128, 128, 128, S, E); }
        if (SUBM & 2) { const SchedGrid2 S = make_grid2(Gq, ck, T / 256, 2, ws + WS_CKV, ws + WS_WK, 2, T / 256, ws + WS_WV, ws + WS_CKV, 128, 128);
          const EpiKV E{Kb, Vtb, ssq_kv};
          pg8::gemm_phase<EpiKV, SchedGrid2, true, false, true>(F.lds, F.wave, 128, 128, 128, S, E); }
        if ((SUBM & 4) && !(PROBE_SKIP == 11 && REPN(2) == 2 && rep == 0)) { const SchedGrid2 S = make_grid2(F.G, (F.vcu + F.G / 2) % F.G, MROWS / 256, 2, ws + WS_MEMN, ws + WS_WMK, 2, MROWS / 256, ws + WS_WMV, ws + WS_MEMN, 1024, 1024);
          const EpiMem E{(bf16*)(ws + WS_MK), (bf16*)(ws + WS_MVT)};
          pg8::gemm_phase<EpiMem, SchedGrid2, true, false>(F.lds, F.wave, 1024, 1024, 1024, S, E); }
        __syncthreads();
        _Pragma("unroll") for (int rep2 = 0; rep2 < REPN(10); ++rep2)
        if (SUBM & 8) for (int u = F.vcu; u < NB * 32; u += F.G) lru_unit<1>(F, u >> 5, u & 31);
        }
        GRID_BAR(2);
    }

    if (IN(3)) { PHASE_PTRS
        bf16* YB = (bf16*)(ws + WS_YB);
        _Pragma("unroll") for (int rep = 0; rep < REPN(3); ++rep)
        if (SUBM & 1) for (int i = 0;; ++i) {
            int bh, qb2;
            if (F.G == 256) { if (i >= 2) break; const int cc = F.vcu & 3; bh = F.vcu >> 2; qb2 = i == 0 ? 7 - cc : cc; }
            else { const int uu = i * F.G + F.vcu; if (uu >= 512) break; bh = uu >> 3; qb2 = 7 - (uu & 7); }
            const int b = bh >> 3, h = bh & 7; const size_t r0 = (size_t)b * SEQ;
            att::unit_g<96, 64, true>(F.lds, F.wave, Qb + (r0 + 512 * qb2) * 768 + h * 96, 768, Kb + r0 * 512 + h * 64, 512, (const bf16*)(dob + DO_KR) + r0 * 32, 32, Vtb + ((size_t)b * 512 + h * 64) * 4096, 4096,
                                (bf16*)((unsigned char*)YB + (r0 + 512 * qb2) * 1024 + h * 64), 1024, 512 * qb2, 8 * (qb2 + 1));
        }
        bf16* QM = (bf16*)(ws + WS_QM); const bf16* MK = (const bf16*)(ws + WS_MK); const bf16* MVT = (const bf16*)(ws + WS_MVT);
        if (SUBM & 2) for (int uu = F.vcu; uu < NB * 4 * 16; uu += F.G) {
            const int b = uu >> 6, h = (uu >> 4) & 3, qb = uu & 15; const size_t r0 = (size_t)b * SEQ + 256 * qb;
            att::unit<128, 128, false, true>(F.lds, F.wave, QM + r0 * 512 + h * 128, 512, MK + (size_t)b * 256 * 512 + h * 128, 512, MVT + ((size_t)b * 512 + h * 128) * 256, 256,
                                       (bf16*)(ws + WS_YC8 + r0 * 1024 + h * 128), 1024, 0, 4);
        }
        if (SUBM & 4) for (int u = F.vcu; u < NB * 32; u += F.G) lru_unit<2>(F, u >> 5, u & 31);
        GRID_BAR(3);
    }

    if (IN(4)) { PHASE_PTRS
        const SchedBranch S{F.G, F.vcu, (const char*)ws};
        EpiBranch E{(const bf16*)(ws + WS_SG), (bf16*)(ws + WS_MG), {}};
#pragma unroll
        for (int k = 0; k < 16; ++k) E.hold[k] = (v2u){0u, 0u};
        _Pragma("unroll") for (int rep = 0; rep < REPN(4); ++rep)
        pg8::gemm_phase<EpiBranch, SchedBranch, true, false, false, true>(F.lds, F.wave, 512, 512, 512, S, E);
        GRID_BAR(4);
    }

    if (IN(5)) { PHASE_PTRS
        const SchedGrid2 S = make_grid1(F.G, F.vcu, T / 256, 4, ws + WS_MG, ws + WS_WO, 1024, 1024);
        _Pragma("unroll") for (int rep = 0; rep < REPN(5); ++rep) {
        const EpiWo E{(const float*)ka->in[0], ka->out, (bf16*)(ws + WS_HB), ssq_h, rep == 0, ws + WS_HB8};
        pg8::gemm_phase<EpiWo, SchedGrid2, true, false>(F.lds, F.wave, 1024, 1024, 1024, S, E); }
        GRID_BAR(5);
    }

    if (IN(6)) { PHASE_PTRS
        const SchedGrid2 S = make_grid1(F.G, F.vcu, T / 256, 1, ws + WS_HB, ws + WS_WR, 1024, 1024);
        const EpiRouter E{ssq_h, (const float*)ka->in[22], (const float*)ka->in[24], gcnt, (int*)(ws + WS_LTOK), (float*)(ws + WS_LW), (int*)(ws + WS_PICK), (float*)(ws + WS_RSH)};
        if (F.G >= T / 256) pg8::gemm_phase<EpiRouter, SchedGrid2, false, false>(F.lds, F.wave, 1024, 1024, 1024, S, E);
        GRID_BAR(6);
    }

    if (IN(7)) { PHASE_PTRS
        const MoeTab tab = moe_tables(F, gcnt);
        const SchedMoe<2, true> S{F.G, F.vcu, tab, (const char*)(ws + WS_HB8), (const char*)(ws + WS_W1), (size_t)512 * 1024, (size_t)256 * 1024, (const int*)(ws + WS_LTOK)};
        const EpiE1 E{(const float*)(ws + WS_RSH), (const int*)(ws + WS_LTOK), (bf16*)(ws + WS_HD), tab};
        _Pragma("unroll") for (int rep = 0; rep < REPN(7); ++rep)
        pg8::gemm_phase<EpiE1, SchedMoe<2, true>, true, true, true>(F.lds, F.wave, 512, 512, 512, S, E);
        GRID_BAR(7);
    }

    if (IN(8)) { PHASE_PTRS
        const MoeTab tab = moe_tables(F, gcnt);
        const SchedMoe<4, false> S{F.G, F.vcu, tab, (const char*)(ws + WS_HD), (const char*)(ws + WS_W2), (size_t)1024 * 256, (size_t)256 * 256, nullptr};
        const EpiE2 E{(const float*)(ws + WS_LW), ws + WS_YE, tab};
        _Pragma("unroll") for (int rep = 0; rep < REPN(8); ++rep)
        pg8::gemm_phase<EpiE2, SchedMoe<4, false>, true, false, true>(F.lds, F.wave, 128, 128, 128, S, E);
        GRID_BAR(8);
    }

    if (IN(9)) { PHASE_PTRS
        const MoeTab tab = moe_tables(F, gcnt);
        const int* pick = (const int*)(ws + WS_PICK); const unsigned char* YE = ws + WS_YE; const float* gfin = (const float*)ka->in[28]; float* outp = ka->out; const bf16* HBp = (const bf16*)(ws + WS_HB);
        const int gw = F.vcu * NWAVES + F.wave, NGW = F.G * NWAVES, lane = F.lane();
        const f32x4* g4 = (const f32x4*)gfin + lane;
#define P9_PICKS(M, MB, P) do { P[0] = pick[2 * (M)]; P[1] = pick[2 * (M) + 1]; P[2] = pick[2 * (MB)]; P[3] = pick[2 * (MB) + 1]; } while (0)
#define P9_LOADS(M, MB, P, WA, WB, EA, EB) do { \
            const unsigned* ya0 = (const unsigned*)(YE + (size_t)(tab.base(P[0] >> 16) + (P[0] & 0xffff)) * DM) + lane; const unsigned* ya1 = (const unsigned*)(YE + (size_t)(tab.base(P[1] >> 16) + (P[1] & 0xffff)) * DM) + lane; \
            const unsigned* yb0 = (const unsigned*)(YE + (size_t)(tab.base(P[2] >> 16) + (P[2] & 0xffff)) * DM) + lane; const unsigned* yb1 = (const unsigned*)(YE + (size_t)(tab.base(P[3] >> 16) + (P[3] & 0xffff)) * DM) + lane; \
            const v2u* ha = (const v2u*)(HBp + (size_t)(M) * DM) + lane; const v2u* hb = (const v2u*)(HBp + (size_t)(MB) * DM) + lane; \
            _Pragma("unroll") for (int j = 0; j < 4; ++j) { WA[j] = ha[64 * j]; EA[j][0] = ya0[64 * j]; EA[j][1] = ya1[64 * j]; WB[j] = hb[64 * j]; EB[j][0] = yb0[64 * j]; EB[j][1] = yb1[64 * j]; } } while (0)
        int pk[4]; v2u wa[4], wb[4]; unsigned ea[4][2], eb[4][2];
        { const int m0 = gw, mb0 = (m0 + NGW < T) ? m0 + NGW : m0; if (m0 < T) { P9_PICKS(m0, mb0, pk); P9_LOADS(m0, mb0, pk, wa, wb, ea, eb); } }
        for (int m = gw; m < T; m += 2 * NGW) {
            const int mb = (m + NGW < T) ? m + NGW : m;
            const int mn = m + 2 * NGW, mbn = (mn + NGW < T) ? mn + NGW : mn; const bool more = mn < T;
            int pn[4] = {0, 0, 0, 0}; if (more) P9_PICKS(mn, mbn, pn);
            f32x4 va[4], vb[4]; float sa = 0.f, sb = 0.f;
#pragma unroll
            for (int j = 0; j < 4; ++j) {
                const f32x2 a0l = __builtin_amdgcn_cvt_pk_f32_fp8((int)ea[j][0], false), a0h = __builtin_amdgcn_cvt_pk_f32_fp8((int)ea[j][0], true), a1l = __builtin_amdgcn_cvt_pk_f32_fp8((int)ea[j][1], false), a1h = __builtin_amdgcn_cvt_pk_f32_fp8((int)ea[j][1], true);
                const f32x2 b0l = __builtin_amdgcn_cvt_pk_f32_fp8((int)eb[j][0], false), b0h = __builtin_amdgcn_cvt_pk_f32_fp8((int)eb[j][0], true), b1l = __builtin_amdgcn_cvt_pk_f32_fp8((int)eb[j][1], false), b1h = __builtin_amdgcn_cvt_pk_f32_fp8((int)eb[j][1], true);
                va[j] = (f32x4){bf_lo(wa[j].x) + a0l[0] + a1l[0], bf_hi(wa[j].x) + a0l[1] + a1l[1], bf_lo(wa[j].y) + a0h[0] + a1h[0], bf_hi(wa[j].y) + a0h[1] + a1h[1]};
                vb[j] = (f32x4){bf_lo(wb[j].x) + b0l[0] + b1l[0], bf_hi(wb[j].x) + b0l[1] + b1l[1], bf_lo(wb[j].y) + b0h[0] + b1h[0], bf_hi(wb[j].y) + b0h[1] + b1h[1]};
                sa += (va[j].x * va[j].x + va[j].y * va[j].y) + (va[j].z * va[j].z + va[j].w * va[j].w); sb += (vb[j].x * vb[j].x + vb[j].y * vb[j].y) + (vb[j].z * vb[j].z + vb[j].w * vb[j].w); }
            if (more) P9_LOADS(mn, mbn, pn, wa, wb, ea, eb);
            const float rsa = rsqrtf(wave_sum(sa) * (1.f / 1024.f) + EPS), rsb = rsqrtf(wave_sum(sb) * (1.f / 1024.f) + EPS);
            f32x4* oa = (f32x4*)(outp + (size_t)m * DM) + lane; f32x4* ob = (f32x4*)(outp + (size_t)mb * DM) + lane;
#pragma unroll
            for (int j = 0; j < 4; ++j) { const f32x4 g = g4[64 * j]; __builtin_nontemporal_store(va[j] * rsa * g, &oa[64 * j]); __builtin_nontemporal_store(vb[j] * rsb * g, &ob[64 * j]); }
        }
#undef P9_PICKS
#undef P9_LOADS
    }
#undef IN
#undef GRID_BAR
}

extern "C" void kernel_launch(void* const* d_in, const int* in_sizes, int n_in, void* d_out, int out_size, void* d_ws, size_t ws_size, hipStream_t stream) {
    static int grid = 0;
    if (grid == 0) {
        if (n_in != 29 || in_sizes[0] != T * DM || out_size != T * DM || ws_size < WS_END) {
            fprintf(stderr, "kernel_launch: unexpected shapes (n_in %d, in0 %d, out %d, ws %zu < %zu); nothing launched\n", n_in, n_in > 0 ? in_sizes[0] : -1, out_size, ws_size, (size_t)WS_END); grid = -1; return; }
        int dev = 0, cus = 0, per_cu = 0;
        if (hipGetDevice(&dev) != hipSuccess || hipDeviceGetAttribute(&cus, hipDeviceAttributeMultiprocessorCount, dev) != hipSuccess) { grid = -1; return; }
        if (hipFuncSetAttribute((const void*)fwd_kernel, hipFuncAttributeMaxDynamicSharedMemorySize, LDS_BYTES) != hipSuccess) { fprintf(stderr, "kernel_launch: hipFuncSetAttribute failed\n"); grid = -1; return; }
        if (hipOccupancyMaxActiveBlocksPerMultiprocessor(&per_cu, (const void*)fwd_kernel, NWAVES * 64, LDS_BYTES) != hipSuccess || per_cu < 1)
            fprintf(stderr, "kernel_launch: note: occupancy query reports %d workgroups per CU\n", per_cu);
        (void)hipGetLastError();
        grid = cus;
    }
    if (grid < 0) return;
    if (hipMemsetAsync((char*)d_ws + WS_CTL, 0, CTL_ZERO_BYTES, stream) != hipSuccess) return;
    Args a{};
    for (int i = 0; i < 29; ++i) a.in[i] = d_in[i];
    a.out = (float*)d_out; a.ws = (unsigned char*)d_ws;
#if MK_SPLIT
    for (int p = 0; p < NPHASE; ++p) { a.ph_lo = p; a.ph_hi = p + 1; hipLaunchKernelGGL(fwd_kernel, dim3(grid), dim3(NWAVES * 64), LDS_BYTES, stream, a); }
#else
    a.ph_lo = 0; a.ph_hi = NPHASE;
    hipLaunchKernelGGL(fwd_kernel, dim3(grid), dim3(NWAVES * 64), LDS_BYTES, stream, a);
#endif
    const hipError_t le = hipPeekAtLastError();
    if (le != hipSuccess) fprintf(stderr, "kernel_launch: launch failed: %s\n", hipGetErrorName(le));
}
```

```cpp
#include <hip/hip_runtime.h>
#include <cstdio>
#include <cstdint>

#define GAS __attribute__((address_space(1)))
#define LAS __attribute__((address_space(3)))
typedef unsigned short bf16;
typedef unsigned v4u __attribute__((ext_vector_type(4)));
typedef unsigned v2u __attribute__((ext_vector_type(2)));
typedef float f32x4 __attribute__((ext_vector_type(4)));
typedef float f32x2 __attribute__((ext_vector_type(2)));
typedef float f32x16 __attribute__((ext_vector_type(16)));
typedef short bf16x8 __attribute__((ext_vector_type(8)));
typedef int i32x4 __attribute__((ext_vector_type(4)));
typedef int i32x8 __attribute__((ext_vector_type(8)));
#define RLX_AGENT __ATOMIC_RELAXED, __HIP_MEMORY_SCOPE_AGENT
#define LDS_WAIT() asm volatile("s_waitcnt lgkmcnt(0)" ::: "memory")
#define VM_WAIT() asm volatile("s_waitcnt vmcnt(0)" ::: "memory")

#ifndef DBG_BR
#define DBG_BR 7
#endif
#ifndef DBG_OUT
#define DBG_OUT 0
#endif
#ifndef PROBE_REP
#define PROBE_REP 0
#endif
#define REPN(k) ((((PROBE_REP) >> (k)) & 1) ? 2 : 1)
#ifndef PROBE_SKIP
#define PROBE_SKIP 0
#endif
#ifndef MK_SPLIT
#define MK_SPLIT 0
#endif

constexpr int NB = 8, SEQ = 4096, T = NB * SEQ, DM = 1024, MEMLEN = 256, MROWS = NB * MEMLEN;
constexpr int NPROJ = 5120;
constexpr int NEXP = 32, DEXP = 256;
constexpr float EPS = 1e-6f;
constexpr float LOG2E = 1.4426950408889634f;
constexpr float C2_MLA = 0.10206207261596575f * LOG2E;
constexpr float C2_MEM = 0.08838834764831845f * LOG2E;
constexpr int NWAVES = 8;
constexpr int MAXTILES = 288;

constexpr size_t MiB = 1u << 20;
constexpr size_t WS_CTL = 0, CTL_ZERO_BYTES = 1 * MiB;
constexpr size_t WS_WIN = 1 * MiB;
constexpr size_t WS_WG8 = 5 * MiB;
constexpr size_t WS_WUQ = 11 * MiB;
constexpr size_t WS_WK = 11 * MiB + 512 * 1024;
constexpr size_t WS_WV = 11 * MiB + 768 * 1024;
constexpr size_t WS_WMK = 12 * MiB;
constexpr size_t WS_WMV = 13 * MiB;
constexpr size_t WS_WBR = 14 * MiB;
constexpr size_t WS_WO = 17 * MiB;
constexpr size_t WS_WR = 19 * MiB;
constexpr size_t WS_WLRU = 19 * MiB + 512 * 1024;
constexpr size_t WS_COS = 20 * MiB, WS_SIN = 22 * MiB;
constexpr size_t WS_W1 = 24 * MiB;
constexpr size_t WS_W2 = 56 * MiB;
constexpr size_t WS_LSUM = 72 * MiB;
constexpr size_t WS_LTOK = 73 * MiB;
constexpr size_t WS_LW = 77 * MiB;
constexpr size_t WS_PICK = 81 * MiB;
constexpr size_t WS_XN = 84 * MiB;
constexpr size_t WS_MG = WS_XN;
constexpr size_t WS_MEMN = 148 * MiB;
constexpr size_t WS_MK = 152 * MiB;
constexpr size_t WS_MVT = 154 * MiB;
constexpr size_t WS_XL = 156 * MiB;
constexpr size_t WS_GL = 188 * MiB;
constexpr size_t WS_HB = 156 * MiB;
constexpr size_t WS_CQ = 220 * MiB;
constexpr size_t WS_CKV = 236 * MiB;
constexpr size_t WS_HB8 = 220 * MiB;
constexpr size_t WS_YB = 220 * MiB;
constexpr size_t WS_QM = 252 * MiB;
constexpr size_t WS_SG = 284 * MiB;
constexpr size_t WS_HD = 284 * MiB;
constexpr size_t WS_YE = 320 * MiB;
constexpr size_t WS_YC8 = 384 * MiB;
constexpr size_t WS_SSQQ = 476 * MiB;
constexpr size_t WS_SSQKV = 476 * MiB + 512 * 1024;
constexpr size_t WS_SSQH = 477 * MiB;
constexpr size_t WS_RSH = 479 * MiB;
constexpr size_t WS_END = 480 * MiB;
constexpr size_t DO_Q = 0, DO_K = 48 * MiB, DO_KR = 80 * MiB, DO_VT = 96 * MiB;
constexpr size_t DO_XN8 = 0;
constexpr float WG8_SCALE = 64.0f, W18_SCALE = 64.0f;
constexpr float WU8_SCALE = 64.0f, CL8_SCALE = 8.0f;
constexpr float W28_SCALE = 64.0f, HD8_SCALE = 8.0f;
constexpr float WB8_SCALE = 64.0f, Y8_SCALE = 32.0f;
#ifndef GATE_UNSCALE
#define GATE_UNSCALE (1.0f / WG8_SCALE)
#endif
constexpr int CW_TMO = 0;
constexpr int CW_BAR = 4096;
constexpr int CW_CNT = 8192;
constexpr int CW_SSQQ = 65536, CW_SSQKV = 65536 + 32768, CW_SSQH = 65536 + 65536;

constexpr int RING_BYTES = 131072;
constexpr int MOE_OFF = RING_BYTES;
constexpr int MISC_OFF = RING_BYTES + 4096;
constexpr int LDS_BYTES = 147456;

__device__ __forceinline__ int lane_id() { unsigned m = ~0u; asm volatile("" : "+s"(m)); return (int)__builtin_amdgcn_mbcnt_hi(m, __builtin_amdgcn_mbcnt_lo(m, 0u)); }
typedef __bf16 bf16x2_t __attribute__((ext_vector_type(2)));
__device__ __forceinline__ unsigned cvt_pk_bf16(float lo, float hi) { f32x2 v = {lo, hi}; bf16x2_t b = __builtin_convertvector(v, bf16x2_t); return __builtin_bit_cast(unsigned, b); }
__device__ __forceinline__ unsigned pk4_fp8(float a, float b, float c, float d) { int w = 0; w = __builtin_amdgcn_cvt_pk_fp8_f32(a, b, w, false); w = __builtin_amdgcn_cvt_pk_fp8_f32(c, d, w, true); return (unsigned)w; }
__device__ __forceinline__ float sat8(float v) { return __builtin_fminf(__builtin_fmaxf(v, -448.0f), 448.0f); }
__device__ __forceinline__ float bf_lo(unsigned w) { return __uint_as_float(w << 16); }
__device__ __forceinline__ float bf_hi(unsigned w) { return __uint_as_float(w & 0xffff0000u); }
__device__ __forceinline__ float bf2f(bf16 b) { return __uint_as_float((unsigned)b << 16); }
__device__ __forceinline__ bf16 f2bf(float f) { return (bf16)(cvt_pk_bf16(f, 0.f) & 0xffffu); }
__device__ __forceinline__ float fast_sigmoid(float x) { return __builtin_amdgcn_rcpf(1.0f + __builtin_amdgcn_exp2f(-x * LOG2E)); }
__device__ __forceinline__ float gelu_tanh(float x) { const float u = 0.7978845608028654f * (x + 0.044715f * x * x * x); return x * fast_sigmoid(2.0f * u); }
__device__ __forceinline__ float wave_sum(float v) {
#pragma unroll
    for (int o = 1; o < 64; o <<= 1) v += __shfl_xor(v, o);
    return v;
}
__device__ __forceinline__ v4u pack8(const f32x4 a, const f32x4 b) { v4u w; w.x = cvt_pk_bf16(a[0], a[1]); w.y = cvt_pk_bf16(a[2], a[3]); w.z = cvt_pk_bf16(b[0], b[1]); w.w = cvt_pk_bf16(b[2], b[3]); return w; }
__device__ __forceinline__ void unpack8(const v4u w, f32x4& a, f32x4& b) { a = (f32x4){bf_lo(w.x), bf_hi(w.x), bf_lo(w.y), bf_hi(w.y)}; b = (f32x4){bf_lo(w.z), bf_hi(w.z), bf_lo(w.w), bf_hi(w.w)}; }

#ifndef FP8_ASM_DMA
#define FP8_ASM_DMA 0
#endif
namespace pg8 {
constexpr int BM = 256, BK = 64, HALF = 128, HTB = HALF * BK * 2, STAGE_BYTES = 8 * HTB;
__host__ __device__ __forceinline__ int lds_byte(int r, int c) { const int st = (r >> 4) * 2 + (c >> 5), rr = r & 15, cc = c & 31, ob = rr * 64 + cc * 2; return st * 1024 + (ob ^ (((ob >> 9) & 1) << 5)); }
__host__ __device__ __forceinline__ void stage_rc(int b, int& R, int& C) { const int st = b / 1024, sb = b % 1024, swz = sb ^ (((sb >> 9) & 1) << 5); R = (st >> 1) * 16 + swz / 64; C = (st & 1) * 32 + (swz % 64) / 2; }
__host__ __device__ __forceinline__ int perm32(int rho) { const int n = rho >> 4, i = rho & 15; return 8 * (i >> 2) + 4 * n + (i & 3); }

__device__ __forceinline__ void glds16s(unsigned voff, const char* sbase, unsigned lds_dst) { unsigned keep;
    asm volatile("s_mov_b32 %0, m0\n\ts_mov_b32 m0, %3\n\ts_nop 0\n\tglobal_load_lds_dwordx4 %1, %2\n\ts_mov_b32 m0, %0" : "=&s"(keep) : "v"(voff), "s"(sbase), "s"(lds_dst) : "memory"); }
struct Unit { int pm, pn, tag, aux; const char* A; const char* B; };

template <class Epi, class Sched, bool ALIGN_EPI, bool GATHER, bool FP8 = false, bool MIX = false>
__device__ __forceinline__ void gemm_phase(LAS unsigned char* lds, const int wave_in, const int K, const int lda, const int ldb, const Sched& S, const Epi& E) {
    const int wid = wave_in, lane = lane_id(), tid = wid * 64 + lane,
              wr = wid >> 2, wc = wid & 3, fr = lane & 15, fq = lane >> 4;
    const int nt = K / BK;
    int Rr[2], Cc[2]; unsigned voffB[2], vA0[2], vA1[2], nA0[2], nA1[2];
#pragma unroll
    for (int i = 0; i < 2; ++i) { stage_rc(tid * 16 + i * 8192, Rr[i], Cc[i]); const int Rb = (Rr[i] & ~31) + perm32(Rr[i] & 31);
        voffB[i] = (unsigned)(Rb * ldb + Cc[i]) * 2u; vA0[i] = (unsigned)(Rr[i] * lda + Cc[i]) * 2u; vA1[i] = vA0[i]; nA0[i] = vA0[i]; nA1[i] = vA0[i]; }
    const size_t kstep = (size_t)(BK * 2);
    const size_t hstepA = GATHER ? (size_t)0 : (size_t)HALF * lda * 2, hstepB = (size_t)HALF * ldb * 2;
    const unsigned ldsw = (unsigned)wid * 1024u;
    const int sc1_ = 0x7F7F7F7F; (void)sc1_;
    const unsigned ldsb = (unsigned)(uintptr_t)lds; (void)ldsb;
    const int aoff = lds_byte(wr * 64 + fr, fq * 8), boff = lds_byte(wc * 32 + fr, fq * 8);
#define PG8_SA(b, h) (((b) * 2 + (h)) * HTB)
#define PG8_SB(b, h) ((4 + (b) * 2 + (h)) * HTB)
#define PG8_STAGE(bufoff, gbase, voff) do { _Pragma("unroll") for (int _i = 0; _i < 2; ++_i) { \
        if constexpr ((FP8 && FP8_ASM_DMA) || MIX) glds16s((voff)[_i], (const char*)(gbase), (unsigned)__builtin_amdgcn_readfirstlane((int)(ldsb + (unsigned)(bufoff) + ldsw + (unsigned)_i * 8192u))); \
        else __builtin_amdgcn_global_load_lds((const unsigned*)((const char*)(gbase) + (voff)[_i]), (LAS unsigned*)(lds + (bufoff) + ldsw + _i * 8192), 16, 0, 0); } } while (0)
#define PG8_LDA(dst, b, h) do { _Pragma("unroll") for (int m = 0; m < 4; ++m) _Pragma("unroll") for (int k = 0; k < 2; ++k) dst[m][k] = *(const LAS bf16x8*)(lds + PG8_SA(b, h) + aoff + m * 2048 + k * 1024); } while (0)
#define PG8_LDB(dst, b, h) do { _Pragma("unroll") for (int n = 0; n < 2; ++n) _Pragma("unroll") for (int k = 0; k < 2; ++k) dst[n][k] = *(const LAS bf16x8*)(lds + PG8_SB(b, h) + boff + n * 2048 + k * 1024); } while (0)
#define PG8_MMAX(F8, ai, bj, At, Bt) do { __builtin_amdgcn_s_setprio(1); _Pragma("unroll") for (int m = 0; m < 4; ++m) _Pragma("unroll") for (int n = 0; n < 2; ++n) { \
        if constexpr (F8) { const i32x4 b0_ = __builtin_bit_cast(i32x4, Bt[n][0]), b1_ = __builtin_bit_cast(i32x4, Bt[n][1]), a0_ = __builtin_bit_cast(i32x4, At[m][0]), a1_ = __builtin_bit_cast(i32x4, At[m][1]); \
            const i32x8 bv_ = {b0_[0], b0_[1], b0_[2], b0_[3], b1_[0], b1_[1], b1_[2], b1_[3]}, av_ = {a0_[0], a0_[1], a0_[2], a0_[3], a1_[0], a1_[1], a1_[2], a1_[3]}; \
            asm volatile("v_mfma_scale_f32_16x16x128_f8f6f4 %0, %1, %2, %0, %3, %3 op_sel_hi:[0,0,0]" : "+v"(acc[ai][bj][m][n]) : "v"(bv_), "v"(av_), "v"(sc1_)); } \
        else { _Pragma("unroll") for (int k = 0; k < 2; ++k) acc[ai][bj][m][n] = __builtin_amdgcn_mfma_f32_16x16x32_bf16(Bt[n][k], At[m][k], acc[ai][bj][m][n], 0, 0, 0); } } \
        __builtin_amdgcn_s_setprio(0); } while (0)
#define PG8_MMA(ai, bj, At, Bt) PG8_MMAX(FP8, ai, bj, At, Bt)
#define PG8_VA1 (GATHER ? vA1 : vA0)
#define PG8_S0 (GATHER ? s0 : vA0)
#define PG8_S1 (GATHER ? s1 : vA0)
#define PG8_WAIT_V(n) asm volatile("s_waitcnt vmcnt(" #n ")" ::: "memory")
#define PG8_WAIT_L(n) asm volatile("s_waitcnt lgkmcnt(" #n ")" ::: "memory")
#define PG8_BAR __builtin_amdgcn_s_barrier()
#define PG8_SCHED __builtin_amdgcn_sched_barrier(0)
#define PG8_KLOOP(F8, NTV) \
        for (int t = 0; t < (NTV); t += 2) { \
            const bool last = (t == (NTV) - 2); \
            const char* a1 = cA + (size_t)(t + 1) * kstep; \
            const char* a2 = last ? nA : cA + (size_t)(t + 2) * kstep; const char* b2 = last ? nB : cB + (size_t)(t + 2) * kstep; \
            const char* a3 = a2 + kstep; const char* b3 = b2 + kstep; \
            unsigned s0[2], s1[2]; \
            _Pragma("unroll") for (int i = 0; i < 2; ++i) { if constexpr (GATHER) { s0[i] = last ? nA0[i] : vA0[i]; s1[i] = last ? nA1[i] : vA1[i]; } else { s0[i] = vA0[i]; s1[i] = vA0[i]; } } \
            (void)s0; (void)s1; \
              \
            PG8_LDB(B0, 0, 0); PG8_LDB(B1, 0, 1); PG8_SCHED; PG8_LDA(At, 0, 0); PG8_STAGE(PG8_SA(1, 1), a1 + hstepA, PG8_VA1); \
            PG8_WAIT_V(8); PG8_WAIT_L(0); PG8_BAR; PG8_MMAX(F8, 0, 0, At, B0); PG8_MMAX(F8, 0, 1, At, B1); PG8_BAR; PG8_SCHED; \
            PG8_LDA(At, 0, 1); PG8_STAGE(PG8_SB(0, 0), b2, voffB); PG8_STAGE(PG8_SB(0, 1), b2 + hstepB, voffB); PG8_STAGE(PG8_SA(0, 0), a2, PG8_S0); \
            PG8_WAIT_V(8); PG8_WAIT_L(0); PG8_BAR; PG8_MMAX(F8, 1, 0, At, B0); PG8_MMAX(F8, 1, 1, At, B1); PG8_BAR; PG8_SCHED; \
              \
            PG8_LDB(B0, 1, 0); PG8_LDB(B1, 1, 1); PG8_SCHED; PG8_LDA(At, 1, 0); PG8_STAGE(PG8_SA(0, 1), a2 + hstepA, PG8_S1); \
            PG8_WAIT_V(8); PG8_WAIT_L(0); PG8_BAR; PG8_MMAX(F8, 0, 0, At, B0); PG8_MMAX(F8, 0, 1, At, B1); PG8_BAR; PG8_SCHED; \
            PG8_LDA(At, 1, 1); PG8_STAGE(PG8_SB(1, 0), b3, voffB); PG8_STAGE(PG8_SB(1, 1), b3 + hstepB, voffB); PG8_STAGE(PG8_SA(1, 0), a3, PG8_S0); \
            PG8_WAIT_V(8); PG8_WAIT_L(0); PG8_BAR; PG8_MMAX(F8, 1, 0, At, B0); PG8_MMAX(F8, 1, 1, At, B1); PG8_BAR; PG8_SCHED; \
        }
    Unit cur, nxt; int ui = 0;
    if (!S.next(0, cur)) return;
    if constexpr (GATHER) {
#pragma unroll
        for (int i = 0; i < 2; ++i) { vA0[i] = (unsigned)(S.grow(cur, Rr[i]) * lda + Cc[i]) * 2u; vA1[i] = (unsigned)(S.grow(cur, HALF + Rr[i]) * lda + Cc[i]) * 2u; }
    }
    f32x4 acc[2][2][4][2];
#pragma unroll
    for (int a = 0; a < 2; ++a)
#pragma unroll
        for (int b = 0; b < 2; ++b)
#pragma unroll
            for (int m = 0; m < 4; ++m)
#pragma unroll
                for (int n = 0; n < 2; ++n) acc[a][b][m][n] = (f32x4){0.f, 0.f, 0.f, 0.f};
    bf16x8 At[4][2], B0[2][2], B1[2][2];
    const char* cA = cur.A; const char* cB = cur.B;
    PG8_STAGE(PG8_SB(0, 0), cB, voffB); PG8_STAGE(PG8_SB(0, 1), cB + hstepB, voffB); PG8_STAGE(PG8_SA(0, 0), cA, vA0); PG8_STAGE(PG8_SA(0, 1), cA + hstepA, PG8_VA1);
    if (wr == 1) PG8_BAR;
    PG8_WAIT_V(2); PG8_BAR;
    PG8_STAGE(PG8_SB(1, 0), cB + kstep, voffB); PG8_STAGE(PG8_SA(1, 0), cA + kstep, vA0); PG8_STAGE(PG8_SB(1, 1), cB + hstepB + kstep, voffB);
    PG8_WAIT_V(6); PG8_BAR;
    for (;;) {
        const bool has_next = S.next(ui + 1, nxt);
        const char* nA = has_next ? nxt.A : cA; const char* nB = has_next ? nxt.B : cB;
        if constexpr (GATHER) {
            if (has_next) {
#pragma unroll
                for (int i = 0; i < 2; ++i) { nA0[i] = (unsigned)(S.grow(nxt, Rr[i]) * lda + Cc[i]) * 2u; nA1[i] = (unsigned)(S.grow(nxt, HALF + Rr[i]) * lda + Cc[i]) * 2u; }
            } else {
#pragma unroll
                for (int i = 0; i < 2; ++i) { nA0[i] = vA0[i]; nA1[i] = vA1[i]; }
            }
        }
        if constexpr (MIX) { if (cur.tag != 0) { PG8_KLOOP(true, nt >> 1); } else { PG8_KLOOP(false, nt); } }
        else { PG8_KLOOP(FP8, nt); }
        if constexpr (ALIGN_EPI) { if (wr == 0) PG8_BAR; }
        if constexpr (FP8 || MIX) asm volatile("s_nop 15\n\ts_nop 7" ::: "memory");
        if constexpr (!Epi::AFTER_DRAIN) { E(acc, cur, wr, wc, fr, fq); }
        if (!has_next) break;
#pragma unroll
        for (int a = 0; a < 2; ++a)
#pragma unroll
            for (int b = 0; b < 2; ++b)
#pragma unroll
                for (int m = 0; m < 4; ++m)
#pragma unroll
                    for (int n = 0; n < 2; ++n) acc[a][b][m][n] = (f32x4){0.f, 0.f, 0.f, 0.f};
        cur = nxt; cA = nA; cB = nB; ++ui;
        if constexpr (GATHER) {
#pragma unroll
            for (int i = 0; i < 2; ++i) { vA0[i] = nA0[i]; vA1[i] = nA1[i]; }
        }
        if constexpr (ALIGN_EPI) { if (wr == 1) PG8_BAR; }
    }
    PG8_WAIT_V(0);
    if constexpr (!ALIGN_EPI) { if (wr == 0) PG8_BAR; }
    PG8_BAR;
    if constexpr (Epi::AFTER_DRAIN) { E.fused(acc, cur, wr, wc, fr, fq, lds, wid, lane); }
#undef PG8_SA
#undef PG8_SB
#undef PG8_STAGE
#undef PG8_LDA
#undef PG8_LDB
#undef PG8_MMA
#undef PG8_MMAX
#undef PG8_KLOOP
#undef PG8_VA1
#undef PG8_S0
#undef PG8_S1
#undef PG8_WAIT_V
#undef PG8_WAIT_L
#undef PG8_BAR
#undef PG8_SCHED
}
}
typedef f32x4 Acc[2][2][4][2];

__device__ __forceinline__ float ssq16(const float* p) { const f32x4 a = *(const f32x4*)p, b = *(const f32x4*)(p + 4), c = *(const f32x4*)(p + 8), d = *(const f32x4*)(p + 12);
    return (((a[0] + a[1]) + (a[2] + a[3])) + ((b[0] + b[1]) + (b[2] + b[3]))) + (((c[0] + c[1]) + (c[2] + c[3])) + ((d[0] + d[1]) + (d[2] + d[3]))); }
struct SchedGrid2 {
    int G, c; int n0, nN0, nN1, ntot; const char *A0, *B0, *A1, *B1; size_t ta, tb; bool xcd;
    __device__ __forceinline__ bool next(int i, pg8::Unit& u) const {
        if (xcd) {
            const int x = c >> 5, q = i * 32 + (c & 31); if (q >= 16 * nN0) return false;
            const int g8 = q / (8 * nN0), r = q % (8 * nN0);
            u.pm = 16 * x + 8 * g8 + (r & 7); u.pn = r >> 3; u.tag = 0; u.aux = 0; u.A = A0 + (size_t)u.pm * ta; u.B = B0 + (size_t)u.pn * tb; return true;
        }
        int L = i * G + c; if (L >= ntot) return false;
        if (L < n0) { u.pm = L / nN0; u.pn = L % nN0; u.tag = 0; u.A = A0 + (size_t)u.pm * ta; u.B = B0 + (size_t)u.pn * tb; }
        else { L -= n0; u.pm = L / nN1; u.pn = L % nN1; u.tag = 1; u.A = A1 + (size_t)u.pm * ta; u.B = B1 + (size_t)u.pn * tb; }
        u.aux = 0; return true;
    }
    __device__ __forceinline__ int grow(const pg8::Unit&, int) const { return 0; }
};
__device__ __forceinline__ SchedGrid2 make_grid1(int G, int c, int nM, int nN, const void* A, const void* B, int lda, int ldb) {
    SchedGrid2 s; s.G = G; s.c = c; s.n0 = nM * nN; s.nN0 = nN; s.nN1 = 1; s.ntot = s.n0; s.A0 = (const char*)A; s.B0 = (const char*)B; s.A1 = s.A0; s.B1 = s.B0;
    s.ta = (size_t)256 * lda * 2; s.tb = (size_t)256 * ldb * 2; s.xcd = (G == 256 && nM == 128); return s;
}
__device__ __forceinline__ SchedGrid2 make_grid2(int G, int c, int nM0, int nN0, const void* A0, const void* B0, int nM1, int nN1, const void* A1, const void* B1, int lda, int ldb) {
    SchedGrid2 s; s.G = G; s.c = c; s.n0 = nM0 * nN0; s.nN0 = nN0; s.nN1 = nN1; s.ntot = s.n0 + nM1 * nN1; s.A0 = (const char*)A0; s.B0 = (const char*)B0; s.A1 = (const char*)A1; s.B1 = (const char*)B1;
    s.ta = (size_t)256 * lda * 2; s.tb = (size_t)256 * ldb * 2; s.xcd = false; return s;
}
struct SchedBranch {
    int G, c; const char *ws;
    __device__ __forceinline__ bool next(int i, pg8::Unit& u) const {
        const int j = i % 3, b = 2 - j; int pm, pn;
        if (G == 256) { const int x = c >> 5, q = (i / 3) * 32 + (c & 31); if (q >= 64) return false; const int g8 = q >> 5, r = q & 31; pm = 16 * x + 8 * g8 + (r & 7); pn = r >> 3; }
        else { const int tile = (i / 3) * G + c; if (tile >= (T / 256) * 4) return false; pm = tile >> 2; pn = tile & 3; }
        u.pm = pm; u.pn = pn; u.tag = b; u.aux = j;
        const size_t yo = b == 0 ? WS_GL : (b == 1 ? WS_YB : WS_YC8);
        u.A = ws + yo + (size_t)u.pm * 256 * 512 * 2; u.B = ws + WS_WBR + ((size_t)b * 1024 + u.pn * 256) * 512 * 2; return true;
    }
    __device__ __forceinline__ int grow(const pg8::Unit&, int) const { return 0; }
};
struct MoeTab { const LAS int* p;
    __device__ __forceinline__ int cnt(int e) const { return p[e]; }
    __device__ __forceinline__ int base(int e) const { return p[32 + e]; }
    __device__ __forceinline__ int ntile() const { return p[64]; }
    __device__ __forceinline__ int tile_e(int t) const { return p[128 + t]; }
    __device__ __forceinline__ int tile_r(int t) const { return p[128 + MAXTILES + t]; }
};
template <int NCOL, bool GATHERED>
struct SchedMoe {
    int G, c; MoeTab tab; const char* Abase; const char* Wbase; size_t wexp, wtile; const int* ltok;
    __device__ __forceinline__ bool next(int i, pg8::Unit& u) const {
        const int L = i * G + c, rt = L / NCOL; if (rt >= tab.ntile()) return false;
        const int e = tab.tile_e(rt), r = tab.tile_r(rt);
        u.pn = L % NCOL; u.tag = e; u.aux = r; u.pm = (tab.base(e) >> 8) + r;
        u.A = GATHERED ? Abase : Abase + (size_t)u.pm * 256 * DEXP;
        u.B = Wbase + (size_t)e * wexp + (size_t)u.pn * wtile; return true;
    }
    __device__ __forceinline__ int grow(const pg8::Unit& u, int r) const {
        const int p = u.aux * 256 + r; return p < tab.cnt(u.tag) ? ltok[u.tag * T + p] : 0;
    }
};

#define EPI_ROWS_BEGIN _Pragma("unroll") for (int ai = 0; ai < 2; ++ai) _Pragma("unroll") for (int m = 0; m < 4; ++m) { const int row = u.pm * 256 + ai * 128 + wr * 64 + m * 16 + fr;
#define EPI_ROWS_END }

struct EpiProj {
    static constexpr bool AFTER_DRAIN = false;
    bf16 *XL, *GL, *CQ, *CKV, *QM, *SG, *KB; float *ssq_q, *ssq_kv; const float *cosT, *sinT; bool side; int pn_off; float gscale;
    __device__ __forceinline__ void operator()(const Acc& acc, const pg8::Unit& u, int wr, int wc, int fr, int fq) const {
        const int pn = u.pn + pn_off, cl = wc * 32 + 8 * fq;
        if (PROBE_SKIP == 9 && side) {
            unsigned char* const tb = (unsigned char*)XL + ((size_t)(u.pm * 8 + pn) << 17) + (wr * 4 + wc) * 16384 + (fq * 16 + fr) * 16;
            EPI_ROWS_BEGIN
#pragma unroll
                for (int bj = 0; bj < 2; ++bj) *(v4u*)(tb + ((ai * 4 + m) * 2 + bj) * 1024) = pack8(acc[ai][bj][m][0], acc[ai][bj][m][1]); (void)row; EPI_ROWS_END
            return;
        }
        if (PROBE_SKIP == 10 && side) {
            EPI_ROWS_BEGIN
#pragma unroll
                for (int bj = 0; bj < 2; ++bj) *(v4u*)(XL + ((size_t)(u.pm * 8 + pn) << 16) + (size_t)(row & 255) * 256 + bj * 128 + cl) = pack8(acc[ai][bj][m][0], acc[ai][bj][m][1]); EPI_ROWS_END
            return;
        }
        if (PROBE_SKIP && PROBE_SKIP != 4 && PROBE_SKIP < 6 && side) return;
        if (DBG_OUT == 2) {
            EPI_ROWS_BEGIN
#pragma unroll
                for (int bj = 0; bj < 2; ++bj) *(v4u*)(XL + (size_t)row * 5120 + pn * 256 + bj * 128 + cl) = pack8(acc[ai][bj][m][0], acc[ai][bj][m][1]); EPI_ROWS_END
        } else if (pn < 2) {
            EPI_ROWS_BEGIN
#pragma unroll
                for (int bj = 0; bj < 2; ++bj) *(v4u*)(XL + (size_t)row * 512 + pn * 256 + bj * 128 + cl) = pack8(acc[ai][bj][m][0], acc[ai][bj][m][1]); EPI_ROWS_END
        } else if (pn < 4) {
            EPI_ROWS_BEGIN
#pragma unroll
                for (int bj = 0; bj < 2; ++bj) { f32x4 a = acc[ai][bj][m][0], b = acc[ai][bj][m][1];
#pragma unroll
                    for (int j = 0; j < 4; ++j) { a[j] = gelu_tanh(a[j]); b[j] = gelu_tanh(b[j]); }
                    *(v4u*)(GL + (size_t)row * 512 + (pn - 2) * 256 + bj * 128 + cl) = pack8(a, b); } EPI_ROWS_END
        } else if (pn == 4) {
            EPI_ROWS_BEGIN
                float s = 0.f;
#pragma unroll
                for (int bj = 0; bj < 2; ++bj) { const f32x4 a = acc[ai][bj][m][0] * gscale, b = acc[ai][bj][m][1] * gscale;
                    s += (a[0] * a[0] + a[1] * a[1]) + (a[2] * a[2] + a[3] * a[3]) + (b[0] * b[0] + b[1] * b[1]) + (b[2] * b[2] + b[3] * b[3]);
                    { v2u c8; c8.x = pk4_fp8(sat8(a[0] * CL8_SCALE), sat8(a[1] * CL8_SCALE), sat8(a[2] * CL8_SCALE), sat8(a[3] * CL8_SCALE)); c8.y = pk4_fp8(sat8(b[0] * CL8_SCALE), sat8(b[1] * CL8_SCALE), sat8(b[2] * CL8_SCALE), sat8(b[3] * CL8_SCALE));
                      *(v2u*)((unsigned char*)CQ + (size_t)row * 256 + bj * 128 + cl) = c8; } }
                s += __shfl_xor(s, 16); s += __shfl_xor(s, 32);
                if (fq == 0) ssq_q[row * 4 + wc] = s; EPI_ROWS_END
        } else if (pn == 5) {
            EPI_ROWS_BEGIN
                { const f32x4 a = acc[ai][0][m][0] * gscale, b = acc[ai][0][m][1] * gscale;
                  float s = (a[0] * a[0] + a[1] * a[1]) + (a[2] * a[2] + a[3] * a[3]) + (b[0] * b[0] + b[1] * b[1]) + (b[2] * b[2] + b[3] * b[3]);
                  { const f32x4 a1 = acc[ai][1][m][0] * gscale, b1 = acc[ai][1][m][1] * gscale; v2u c8;
                    c8.x = pk4_fp8(sat8(a[0] * CL8_SCALE), sat8(a[1] * CL8_SCALE), sat8(a[2] * CL8_SCALE), sat8(a[3] * CL8_SCALE)); c8.y = pk4_fp8(sat8(b[0] * CL8_SCALE), sat8(b[1] * CL8_SCALE), sat8(b[2] * CL8_SCALE), sat8(b[3] * CL8_SCALE));
                    *(v2u*)((unsigned char*)CKV + (size_t)row * 256 + cl) = c8;
                    c8.x = pk4_fp8(sat8(a1[0] * CL8_SCALE), sat8(a1[1] * CL8_SCALE), sat8(a1[2] * CL8_SCALE), sat8(a1[3] * CL8_SCALE)); c8.y = pk4_fp8(sat8(b1[0] * CL8_SCALE), sat8(b1[1] * CL8_SCALE), sat8(b1[2] * CL8_SCALE), sat8(b1[3] * CL8_SCALE));
                    *(v2u*)((unsigned char*)CKV + (size_t)row * 256 + 128 + cl) = c8; }
                  s += __shfl_xor(s, 16); s += __shfl_xor(s, 32);
                  if (fq == 0) ssq_kv[row * 4 + wc] = s; }
                if (wc == 0) {
                    const f32x4 a = acc[ai][1][m][0] * gscale, b = acc[ai][1][m][1] * gscale;
                    const f32x4 cs = *(const f32x4*)(cosT + (size_t)row * 16 + 4 * fq), sn = *(const f32x4*)(sinT + (size_t)row * 16 + 4 * fq);
                    f32x4 oa, ob;
                    oa[0] = a[0] * cs[0] - a[1] * sn[0]; oa[1] = a[1] * cs[0] + a[0] * sn[0]; oa[2] = a[2] * cs[1] - a[3] * sn[1]; oa[3] = a[3] * cs[1] + a[2] * sn[1];
                    ob[0] = b[0] * cs[2] - b[1] * sn[2]; ob[1] = b[1] * cs[2] + b[0] * sn[2]; ob[2] = b[2] * cs[3] - b[3] * sn[3]; ob[3] = b[3] * cs[3] + b[2] * sn[3];
                    *(v4u*)(KB + (size_t)row * 32 + 8 * fq) = pack8(oa, ob);
                } EPI_ROWS_END
        } else if (pn < 8) {
            EPI_ROWS_BEGIN
#pragma unroll
                for (int bj = 0; bj < 2; ++bj) *(v4u*)(QM + (size_t)row * 512 + (pn - 6) * 256 + bj * 128 + cl) = pack8(acc[ai][bj][m][0] * (C2_MEM * gscale), acc[ai][bj][m][1] * (C2_MEM * gscale)); EPI_ROWS_END
        } else {
            unsigned char* const sgl = (unsigned char*)SG + ((size_t)(u.pm * 12 + pn - 8) << 16);
            const unsigned lo = (unsigned)((((wr * 4 + wc) * 16) * 64 + fq * 16 + fr) << 3);
            EPI_ROWS_BEGIN
#pragma unroll
                for (int bj = 0; bj < 2; ++bj) { f32x4 a = acc[ai][bj][m][0], b = acc[ai][bj][m][1];
#pragma unroll
                    for (int j = 0; j < 4; ++j) { a[j] = fast_sigmoid(a[j] * gscale) * 255.0f + 0.5f; b[j] = fast_sigmoid(b[j] * gscale) * 255.0f + 0.5f; }
                    unsigned o = lo; asm volatile("" : "+v"(o)); unsigned char* const sp = sgl + o;
                    v2u w; w.x = (unsigned)a[0] | ((unsigned)a[1] << 8) | ((unsigned)a[2] << 16) | ((unsigned)a[3] << 24); w.y = (unsigned)b[0] | ((unsigned)b[1] << 8) | ((unsigned)b[2] << 16) | ((unsigned)b[3] << 24);
                    *(v2u*)(sp + ((ai * 4 + m) * 2 + bj) * 512) = w; (void)row; } EPI_ROWS_END
        }
    }
};
struct EpiGate {
    static constexpr bool AFTER_DRAIN = false;
    unsigned char* SG; float gscale; bool skip;
    __device__ __forceinline__ void operator()(const Acc& acc, const pg8::Unit& u, int wr, int wc, int fr, int fq) const {
        if (PROBE_SKIP && PROBE_SKIP < 5 && skip) return;
        unsigned char* const sgl = SG + ((size_t)(u.pm * 12 + u.pn) << 16);
        const unsigned lo = (unsigned)((((wr * 4 + wc) * 16) * 64 + fq * 16 + fr) << 3);
#pragma unroll
        for (int ai = 0; ai < 2; ++ai)
#pragma unroll
            for (int m = 0; m < 4; ++m)
#pragma unroll
                for (int bj = 0; bj < 2; ++bj) { f32x4 a = acc[ai][bj][m][0], b = acc[ai][bj][m][1];
#pragma unroll
                    for (int j = 0; j < 4; ++j) { a[j] = fast_sigmoid(a[j] * gscale) * 255.0f + 0.5f; b[j] = fast_sigmoid(b[j] * gscale) * 255.0f + 0.5f; }
                    unsigned o = lo; asm volatile("" : "+v"(o));
                    v2u w; w.x = (unsigned)a[0] | ((unsigned)a[1] << 8) | ((unsigned)a[2] << 16) | ((unsigned)a[3] << 24); w.y = (unsigned)b[0] | ((unsigned)b[1] << 8) | ((unsigned)b[2] << 16) | ((unsigned)b[3] << 24);
                    *(v2u*)(sgl + o + ((ai * 4 + m) * 2 + bj) * 512) = w; }
    }
};
struct EpiQ {
    static constexpr bool AFTER_DRAIN = false;
    bf16* Q; const float* ssq_q; const float *cosT, *sinT;
    __device__ __forceinline__ void operator()(const Acc& acc, const pg8::Unit& u, int wr, int wc, int fr, int fq) const {
        const int cl = wc * 32 + 8 * fq;
        EPI_ROWS_BEGIN
            const f32x4 sq4 = *(const f32x4*)(ssq_q + row * 4); const float rs = rsqrtf(((sq4[0] + sq4[1]) + (sq4[2] + sq4[3])) * (1.0f / 256.0f) + EPS) * (1.0f / (WU8_SCALE * CL8_SCALE));
#pragma unroll
            for (int bj = 0; bj < 2; ++bj) { const int c = u.pn * 256 + bj * 128 + cl, d = c % 96;
                f32x4 a = acc[ai][bj][m][0] * rs, b = acc[ai][bj][m][1] * rs;
                if (d >= 64) { const int i0 = (d - 64) >> 1;
                    const f32x4 cs = *(const f32x4*)(cosT + (size_t)row * 16 + i0), sn = *(const f32x4*)(sinT + (size_t)row * 16 + i0);
                    f32x4 oa, ob;
                    oa[0] = a[0] * cs[0] - a[1] * sn[0]; oa[1] = a[1] * cs[0] + a[0] * sn[0]; oa[2] = a[2] * cs[1] - a[3] * sn[1]; oa[3] = a[3] * cs[1] + a[2] * sn[1];
                    ob[0] = b[0] * cs[2] - b[1] * sn[2]; ob[1] = b[1] * cs[2] + b[0] * sn[2]; ob[2] = b[2] * cs[3] - b[3] * sn[3]; ob[3] = b[3] * cs[3] + b[2] * sn[3];
                    a = oa; b = ob; }
                *(v4u*)(Q + (size_t)row * 768 + c) = pack8(a * C2_MLA, b * C2_MLA); } EPI_ROWS_END
    }
};
struct EpiKV {
    static constexpr bool AFTER_DRAIN = false;
    bf16 *KB, *VT; const float* ssq_kv;
    __device__ __forceinline__ void operator()(const Acc& acc, const pg8::Unit& u, int wr, int wc, int fr, int fq) const {
        const int cl = wc * 32 + 8 * fq;
        if (u.tag == 0) {
            EPI_ROWS_BEGIN
                const f32x4 sq4 = *(const f32x4*)(ssq_kv + row * 4); const float rs = rsqrtf(((sq4[0] + sq4[1]) + (sq4[2] + sq4[3])) * (1.0f / 128.0f) + EPS) * (1.0f / (WU8_SCALE * CL8_SCALE));
#pragma unroll
                for (int bj = 0; bj < 2; ++bj) { const int c = u.pn * 256 + bj * 128 + cl;
                    *(v4u*)(KB + (size_t)row * 512 + c) = pack8(acc[ai][bj][m][0] * rs, acc[ai][bj][m][1] * rs); } EPI_ROWS_END
        } else {
            f32x4 rsa[2], rsb[2]; size_t cb[2];
#pragma unroll
            for (int bj = 0; bj < 2; ++bj) { const int t0 = u.pn * 256 + bj * 128 + cl;
#pragma unroll
                for (int j = 0; j < 4; ++j) { const f32x4 qa = *(const f32x4*)(ssq_kv + (t0 + j) * 4), qb = *(const f32x4*)(ssq_kv + (t0 + 4 + j) * 4);
                    rsa[bj][j] = rsqrtf(((qa[0] + qa[1]) + (qa[2] + qa[3])) * (1.0f / 128.0f) + EPS) * (1.0f / (WU8_SCALE * CL8_SCALE)); rsb[bj][j] = rsqrtf(((qb[0] + qb[1]) + (qb[2] + qb[3])) * (1.0f / 128.0f) + EPS) * (1.0f / (WU8_SCALE * CL8_SCALE)); }
                cb[bj] = (size_t)(t0 >> 12) * 512 * 4096 + (t0 & 4095); }
            EPI_ROWS_BEGIN
#pragma unroll
                for (int bj = 0; bj < 2; ++bj) *(v4u*)(VT + cb[bj] + (size_t)row * 4096) = pack8(acc[ai][bj][m][0] * rsa[bj], acc[ai][bj][m][1] * rsb[bj]); EPI_ROWS_END
        }
    }
};
struct EpiMem {
    static constexpr bool AFTER_DRAIN = false;
    bf16 *MK, *MVT;
    __device__ __forceinline__ void operator()(const Acc& acc, const pg8::Unit& u, int wr, int wc, int fr, int fq) const {
        const int cl = wc * 32 + 8 * fq;
        if (u.tag == 0) {
            EPI_ROWS_BEGIN
#pragma unroll
                for (int bj = 0; bj < 2; ++bj) *(v4u*)(MK + (size_t)row * 512 + u.pn * 256 + bj * 128 + cl) = pack8(acc[ai][bj][m][0], acc[ai][bj][m][1]); EPI_ROWS_END
        } else {
            EPI_ROWS_BEGIN
#pragma unroll
                for (int bj = 0; bj < 2; ++bj) *(v4u*)(MVT + ((size_t)u.pn * 512 + row) * 256 + bj * 128 + cl) = pack8(acc[ai][bj][m][0], acc[ai][bj][m][1]); EPI_ROWS_END
        }
    }
};
struct EpiBranch {
    static constexpr bool AFTER_DRAIN = false;
    const bf16* SG; bf16* MG;
    mutable v2u hold[16];
    template <int ST>
    __device__ __forceinline__ void stage(const Acc& acc, const pg8::Unit& u, int wr, int wc, int fr_, int fq_) const {
        constexpr int b = 2 - ST;
        const int ln = lane_id(); (void)fr_; (void)fq_;
        const int fr = ln & 15, fq = ln >> 4, cl = wc * 32 + 8 * fq;
        const size_t lb = (size_t)((((wr * 4 + wc) * 16) * 64 + fq * 16 + fr) << 3);
        const unsigned char* const gl = (const unsigned char*)SG + ((size_t)(u.pm * 12 + b * 4 + u.pn) << 16) + lb;
        constexpr float q = b ? (1.0f / 255.0f) / (WB8_SCALE * Y8_SCALE) : 1.0f / 255.0f;
#pragma unroll
        for (int ai = 0; ai < 2; ++ai) {
            v2u gw[4][2];
#pragma unroll
            for (int m = 0; m < 4; ++m)
#pragma unroll
                for (int bj = 0; bj < 2; ++bj) gw[m][bj] = *(const v2u*)(gl + ((ai * 4 + m) * 2 + bj) * 512);
#pragma unroll
            for (int m = 0; m < 4; ++m) { const int row = u.pm * 256 + ai * 128 + wr * 64 + m * 16 + fr;
#pragma unroll
                for (int bj = 0; bj < 2; ++bj) { const int c = u.pn * 256 + bj * 128 + cl, k = (ai * 4 + m) * 2 + bj;
                    f32x4 ga, gb;
                    { const unsigned g0 = gw[m][bj].x, g1 = gw[m][bj].y;
                      ga = (f32x4){(float)(g0 & 255u) * q, (float)((g0 >> 8) & 255u) * q, (float)((g0 >> 16) & 255u) * q, (float)(g0 >> 24) * q};
                      gb = (f32x4){(float)(g1 & 255u) * q, (float)((g1 >> 8) & 255u) * q, (float)((g1 >> 16) & 255u) * q, (float)(g1 >> 24) * q}; }
                    f32x4 a = acc[ai][bj][m][0] * ga, bb = acc[ai][bj][m][1] * gb;
                    if (!((DBG_BR >> b) & 1)) { a = (f32x4){0.f, 0.f, 0.f, 0.f}; bb = a; }
                    if constexpr (ST > 0) { const f32x2 h0 = __builtin_amdgcn_cvt_pk_f32_fp8((int)hold[k].x, false), h1 = __builtin_amdgcn_cvt_pk_f32_fp8((int)hold[k].x, true), h2 = __builtin_amdgcn_cvt_pk_f32_fp8((int)hold[k].y, false), h3 = __builtin_amdgcn_cvt_pk_f32_fp8((int)hold[k].y, true);
                        a += (f32x4){h0[0], h0[1], h1[0], h1[1]}; bb += (f32x4){h2[0], h2[1], h3[0], h3[1]}; }
                    if constexpr (ST < 2) { hold[k].x = pk4_fp8(a[0], a[1], a[2], a[3]); hold[k].y = pk4_fp8(bb[0], bb[1], bb[2], bb[3]); }
                    else *(v4u*)(MG + (size_t)row * 1024 + c) = pack8(a, bb); } }
        }
    }
    __device__ __forceinline__ void operator()(const Acc& acc, const pg8::Unit& u, int wr, int wc, int fr, int fq) const {
        if (u.aux == 0) stage<0>(acc, u, wr, wc, fr, fq); else if (u.aux == 1) stage<1>(acc, u, wr, wc, fr, fq); else stage<2>(acc, u, wr, wc, fr, fq);
    }
};
struct EpiWo {
    static constexpr bool AFTER_DRAIN = false;
    const float* x; float* out; bf16* HB; float* ssq_h; bool side; unsigned char* HB8;
    __device__ __forceinline__ void operator()(const Acc& acc, const pg8::Unit& u, int wr, int wc, int fr, int fq) const {
        const int cl = wc * 32 + 8 * fq;
        f32x4 xa[2][2][2], xb[2][2][2];
#define WO_LOAD(k) do { _Pragma("unroll") for (int mm = 0; mm < 2; ++mm) _Pragma("unroll") for (int bj = 0; bj < 2; ++bj) { \
            const size_t off = (size_t)(u.pm * 256 + ((k) >> 1) * 128 + wr * 64 + (((k) & 1) * 2 + mm) * 16 + fr) * 1024 + u.pn * 256 + bj * 128 + cl; \
            xa[(k) & 1][mm][bj] = *(const f32x4*)(x + off); xb[(k) & 1][mm][bj] = *(const f32x4*)(x + off + 4); } } while (0)
        WO_LOAD(0);
#pragma unroll
        for (int k = 0; k < 4; ++k) { const int ai = k >> 1, mh = k & 1;
                if (k < 3) WO_LOAD(k + 1);
#pragma unroll
                for (int mm = 0; mm < 2; ++mm) { const int m = mh * 2 + mm, row = u.pm * 256 + ai * 128 + wr * 64 + m * 16 + fr; float s = 0.f;
#pragma unroll
                    for (int bj = 0; bj < 2; ++bj) { const size_t off = (size_t)row * 1024 + u.pn * 256 + bj * 128 + cl;
                        const f32x4 a = xa[k & 1][mm][bj] + acc[ai][bj][m][0], b = xb[k & 1][mm][bj] + acc[ai][bj][m][1];
                        *(v4u*)(HB + off) = pack8(a, b); { v2u h8; h8.x = pk4_fp8(a[0], a[1], a[2], a[3]); h8.y = pk4_fp8(b[0], b[1], b[2], b[3]); *(v2u*)(HB8 + off) = h8; }
                        s += (a[0] * a[0] + a[1] * a[1]) + (a[2] * a[2] + a[3] * a[3]) + (b[0] * b[0] + b[1] * b[1]) + (b[2] * b[2] + b[3] * b[3]); }
                    s += __shfl_xor(s, 16); s += __shfl_xor(s, 32);
                    if (fq == 0) ssq_h[row * 16 + u.pn * 4 + wc] = s; }
        }
#undef WO_LOAD
    }
};
struct EpiRouter {
    static constexpr bool AFTER_DRAIN = true;
    const float* ssq_h; const float *b_group, *b_router; unsigned* gcnt; int* ltok; float* lw; int* pick; float* rsh;
    __device__ __forceinline__ void fused(Acc& acc, const pg8::Unit& u, int wr, int wc, int fr, int fq, LAS unsigned char* lds, int wid, int lane) const {
        LAS unsigned* lcnt = (LAS unsigned*)lds; LAS unsigned* lbase = lcnt + 32;
        const int tix = wid * 64 + lane;
        if (tix < 32) lcnt[tix] = 0u;
        __syncthreads();
        int pe0[8], pe1[8], pp0[8], pp1[8]; float pw0[8], pw1[8];
        if (wc == 0) {
            const f32x4 bg = *(const f32x4*)b_group;
#pragma unroll
            for (int ai = 0; ai < 2; ++ai)
#pragma unroll
                for (int m = 0; m < 4; ++m) {
                    const int row = u.pm * 256 + ai * 128 + wr * 64 + m * 16 + fr, k = ai * 4 + m;
                    const float rs = rsqrtf(ssq16(ssq_h + row * 16) * (1.0f / 1024.0f) + EPS);
                    if (fq == 0) rsh[row] = rs;
                    const f32x4 gl = acc[ai][1][m][0] * rs + bg;
                    int g = 0; float gm = gl[0];
#pragma unroll
                    for (int j = 1; j < 4; ++j) if (gl[j] > gm) { gm = gl[j]; g = j; }
                    float den = 0.f;
#pragma unroll
                    for (int j = 0; j < 4; ++j) den += __expf(gl[j] - gm);
                    float gwt = 1.0f / den;
                    g = __shfl(g, fr); gwt = __shfl(gwt, fr);
                    const f32x4 ba = *(const f32x4*)(b_router + 8 * fq), bb = *(const f32x4*)(b_router + 8 * fq + 4);
                    const f32x4 la = acc[ai][0][m][0] * rs + ba, lb = acc[ai][0][m][1] * rs + bb;
                    float v[8] = {la[0], la[1], la[2], la[3], lb[0], lb[1], lb[2], lb[3]};
                    int i1 = 0; float v1 = v[0];
#pragma unroll
                    for (int j = 1; j < 8; ++j) if (v[j] > v1) { v1 = v[j]; i1 = j; }
                    int i2 = -1; float v2 = -INFINITY;
#pragma unroll
                    for (int j = 0; j < 8; ++j) if (j != i1 && v[j] > v2) { v2 = v[j]; i2 = j; }
                    const float w1 = gwt / (1.0f + __expf(v2 - v1)), w2 = gwt - w1;
                    pe0[k] = -1; pe1[k] = -1; pp0[k] = 0; pp1[k] = 0; pw0[k] = w1; pw1[k] = w2;
                    if (fq == g) { pe0[k] = 8 * g + i1; pe1[k] = 8 * g + i2;
                        pp0[k] = (int)__hip_atomic_fetch_add(lcnt + pe0[k], 1u, __ATOMIC_RELAXED, __HIP_MEMORY_SCOPE_WORKGROUP);
                        pp1[k] = (int)__hip_atomic_fetch_add(lcnt + pe1[k], 1u, __ATOMIC_RELAXED, __HIP_MEMORY_SCOPE_WORKGROUP); }
                }
        }
        __syncthreads();
        if (tix < 32) { const unsigned n = lcnt[tix]; lbase[tix] = n ? __hip_atomic_fetch_add(gcnt + tix, n, RLX_AGENT) : 0u; }
        __syncthreads();
        if (wc == 0) {
#pragma unroll
            for (int ai = 0; ai < 2; ++ai)
#pragma unroll
                for (int m = 0; m < 4; ++m) {
                    const int row = u.pm * 256 + ai * 128 + wr * 64 + m * 16 + fr, k = ai * 4 + m;
                    if (pe0[k] >= 0) {
                        const int e0 = pe0[k], e1 = pe1[k], s0 = (int)lbase[e0] + pp0[k], s1 = (int)lbase[e1] + pp1[k];
                        ltok[e0 * T + s0] = row; lw[e0 * T + s0] = pw0[k]; ltok[e1 * T + s1] = row; lw[e1 * T + s1] = pw1[k];
                        pick[row * 2] = (e0 << 16) | s0; pick[row * 2 + 1] = (e1 << 16) | s1;
                    }
                }
        }
    }
};
struct EpiE1 {
    static constexpr bool AFTER_DRAIN = false;
    const float* rsh; const int* ltok; bf16* HD; MoeTab tab;
    __device__ __forceinline__ void operator()(const Acc& acc, const pg8::Unit& u, int wr, int wc, int fr, int fq) const {
        const int cl = wc * 32 + 8 * fq, e = u.tag, cnt = tab.cnt(e);
        const int ln = lane_id();
        unsigned char* const hdl = (unsigned char*)HD + (size_t)(u.pm * 256 + wr * 64 + (ln & 15)) * 256 + u.pn * 128 + wc * 32 + 8 * (ln >> 4);
        int tok[8]; float sq[8];
#pragma unroll
        for (int k = 0; k < 8; ++k) { const int p = u.aux * 256 + (k >> 2) * 128 + wr * 64 + (k & 3) * 16 + fr; tok[k] = p < cnt ? ltok[e * T + p] : 0; }
#pragma unroll
        for (int k = 0; k < 8; ++k) sq[k] = rsh[tok[k]];
        EPI_ROWS_BEGIN
            const int p = u.aux * 256 + ai * 128 + wr * 64 + m * 16 + fr;
            if (p < cnt) { const float rs = sq[ai * 4 + m] * (1.0f / W18_SCALE);
                f32x4 a, b;
#pragma unroll
                for (int j = 0; j < 4; ++j) { const float g0 = acc[ai][0][m][0][j] * rs, u0 = acc[ai][1][m][0][j] * rs, g1 = acc[ai][0][m][1][j] * rs, u1 = acc[ai][1][m][1][j] * rs;
                    a[j] = g0 * fast_sigmoid(g0) * u0; b[j] = g1 * fast_sigmoid(g1) * u1; }
                v2u h8; h8.x = pk4_fp8(sat8(a[0] * HD8_SCALE), sat8(a[1] * HD8_SCALE), sat8(a[2] * HD8_SCALE), sat8(a[3] * HD8_SCALE)); h8.y = pk4_fp8(sat8(b[0] * HD8_SCALE), sat8(b[1] * HD8_SCALE), sat8(b[2] * HD8_SCALE), sat8(b[3] * HD8_SCALE));
                *(v2u*)(hdl + (size_t)(ai * 128 + m * 16) * 256) = h8; (void)row; } EPI_ROWS_END
    }
};
struct EpiE2 {
    static constexpr bool AFTER_DRAIN = false;
    const float* lw; unsigned char* YE; MoeTab tab;
    __device__ __forceinline__ void operator()(const Acc& acc, const pg8::Unit& u, int wr, int wc, int fr, int fq) const {
        const int cl = wc * 32 + 8 * fq, e = u.tag, cnt = tab.cnt(e);
        EPI_ROWS_BEGIN
            const int p = u.aux * 256 + ai * 128 + wr * 64 + m * 16 + fr;
            if (p < cnt) { const float w = lw[e * T + p] * (1.0f / (W28_SCALE * HD8_SCALE));
#pragma unroll
                for (int bj = 0; bj < 2; ++bj) { const f32x4 a = acc[ai][bj][m][0] * w, b = acc[ai][bj][m][1] * w; v2u y8; y8.x = pk4_fp8(a[0], a[1], a[2], a[3]); y8.y = pk4_fp8(b[0], b[1], b[2], b[3]);
                    *(v2u*)(YE + (size_t)row * 1024 + u.pn * 256 + bj * 128 + cl) = y8; } } EPI_ROWS_END
    }
};

namespace att {
__device__ __forceinline__ float pmax(float m) { auto rr = __builtin_amdgcn_permlane32_swap(__float_as_uint(m), __float_as_uint(m), false, false); return fmaxf(__uint_as_float(rr[0]), __uint_as_float(rr[1])); }
__device__ __forceinline__ float psum(float m) { auto rr = __builtin_amdgcn_permlane32_swap(__float_as_uint(m), __float_as_uint(m), false, false); return __uint_as_float(rr[0]) + __uint_as_float(rr[1]); }
template <int DQK, int DV, bool CAUSAL, bool O8 = false>
__device__ __forceinline__ void unit(LAS unsigned char* lds, const int wave_in, const bf16* Qp, int qp, const bf16* Kp, int kp, const bf16* Vp, int vp, bf16* Op, int op, int q0, int NT) {
    constexpr int KST = DQK * 2 + 16, VST = 144, KBUF = 64 * KST, VBUF = DV * VST;
    constexpr int NCK = DQK / 8, TOTK = 64 * NCK, TOTV = DV * 8, NKI = (TOTK + 511) / 512, NVI = (TOTV + 511) / 512, ND0 = DQK / 16, NDT = DV / 32;
    const int wid = wave_in, lane = lane_id(), tid = wid * 64 + lane, r32 = lane & 31, hi = lane >> 5;
    const bf16* ksrc[NKI]; int kdst[NKI]; bool kval[NKI]; const bf16* vsrc[NVI]; int vdst[NVI];
#pragma unroll
    for (int i = 0; i < NKI; ++i) { const int id = tid + 512 * i; kval[i] = id < TOTK; const int idc = kval[i] ? id : 0, kr = idc / NCK, j = idc % NCK;
        const int rho = (kr & ~12) | ((kr & 4) << 1) | ((kr & 8) >> 1);
        ksrc[i] = Kp + (size_t)kr * kp + 8 * j; kdst[i] = rho * KST + 16 * j; }
#pragma unroll
    for (int i = 0; i < NVI; ++i) { const int id = tid + 512 * i, d = id >> 3, j = id & 7; vsrc[i] = Vp + (size_t)d * vp + 8 * j; vdst[i] = d * VST + 16 * j; }
    v4u kreg[NKI], vreg[NVI];
#define ATT_LOAD(t) do { _Pragma("unroll") for (int i = 0; i < NKI; ++i) kreg[i] = kval[i] ? *(const v4u*)(ksrc[i] + (size_t)(t) * 64 * kp) : (v4u){0u, 0u, 0u, 0u}; \
                         _Pragma("unroll") for (int i = 0; i < NVI; ++i) vreg[i] = *(const v4u*)(vsrc[i] + (size_t)(t) * 64); } while (0)
#define ATT_STORE(b) do { _Pragma("unroll") for (int i = 0; i < NKI; ++i) if (kval[i]) *(LAS v4u*)(lds + (b) * KBUF + kdst[i]) = kreg[i]; \
                          _Pragma("unroll") for (int i = 0; i < NVI; ++i) *(LAS v4u*)(lds + 2 * KBUF + (b) * VBUF + vdst[i]) = vreg[i]; } while (0)
    ATT_LOAD(0);
    bf16x8 qr[ND0];
    { const bf16* qrow = Qp + (size_t)(32 * wid + r32) * qp + hi * 8;
#pragma unroll
      for (int d0 = 0; d0 < ND0; ++d0) qr[d0] = *(const bf16x8*)(qrow + d0 * 16); }
    ATT_STORE(0);
    __syncthreads();
    f32x16 o[NDT];
#pragma unroll
    for (int dt = 0; dt < NDT; ++dt)
#pragma unroll
        for (int r = 0; r < 16; ++r) o[dt][r] = 0.f;
    float mrun = -INFINITY, lsum = 0.f;
    const int qbase = q0 + 32 * wid, qrow_i = qbase + r32;
    for (int t = 0; t < NT; ++t) {
        const int b = t & 1;
        if (t + 1 < NT) ATT_LOAD(t + 1);
        if (!CAUSAL || 64 * t <= qbase + 31) {
            const LAS unsigned char* kb = lds + b * KBUF + r32 * KST + hi * 16;
            f32x16 p0, p1;
#pragma unroll
            for (int r = 0; r < 16; ++r) { p0[r] = 0.f; p1[r] = 0.f; }
#pragma unroll
            for (int d0 = 0; d0 < ND0; ++d0) {
                const bf16x8 a0 = *(const LAS bf16x8*)(kb + d0 * 32), a1 = *(const LAS bf16x8*)(kb + 32 * KST + d0 * 32);
                p0 = __builtin_amdgcn_mfma_f32_32x32x16_bf16(a0, qr[d0], p0, 0, 0, 0);
                p1 = __builtin_amdgcn_mfma_f32_32x32x16_bf16(a1, qr[d0], p1, 0, 0, 0);
                if (DQK > 96 && (d0 & 1)) __builtin_amdgcn_sched_barrier(0);
            }
            if (CAUSAL && 64 * t + 63 > qbase) {
#pragma unroll
                for (int r = 0; r < 16; ++r) { const int key = 64 * t + 16 * (r >> 3) + 8 * hi + (r & 7);
                    if (key > qrow_i) p0[r] = -INFINITY; if (key + 32 > qrow_i) p1[r] = -INFINITY; }
            }
            float mt = fmaxf(p0[0], p1[0]);
#pragma unroll
            for (int r = 1; r < 16; ++r) mt = fmaxf(mt, fmaxf(p0[r], p1[r]));
            mt = pmax(mt);
            const float mnew = fmaxf(mrun, mt), sc = __builtin_amdgcn_exp2f(mrun - mnew);
            mrun = mnew;
            float ps = 0.f;
#pragma unroll
            for (int r = 0; r < 16; ++r) { p0[r] = __builtin_amdgcn_exp2f(p0[r] - mnew); p1[r] = __builtin_amdgcn_exp2f(p1[r] - mnew); ps += p0[r] + p1[r]; }
            lsum = lsum * sc + ps;
#pragma unroll
            for (int dt = 0; dt < NDT; ++dt)
#pragma unroll
                for (int r = 0; r < 16; ++r) o[dt][r] *= sc;
            bf16x8 pf[4];
            { v4u w;
              w.x = cvt_pk_bf16(p0[0], p0[1]); w.y = cvt_pk_bf16(p0[2], p0[3]); w.z = cvt_pk_bf16(p0[4], p0[5]); w.w = cvt_pk_bf16(p0[6], p0[7]); pf[0] = __builtin_bit_cast(bf16x8, w);
              w.x = cvt_pk_bf16(p0[8], p0[9]); w.y = cvt_pk_bf16(p0[10], p0[11]); w.z = cvt_pk_bf16(p0[12], p0[13]); w.w = cvt_pk_bf16(p0[14], p0[15]); pf[1] = __builtin_bit_cast(bf16x8, w);
              w.x = cvt_pk_bf16(p1[0], p1[1]); w.y = cvt_pk_bf16(p1[2], p1[3]); w.z = cvt_pk_bf16(p1[4], p1[5]); w.w = cvt_pk_bf16(p1[6], p1[7]); pf[2] = __builtin_bit_cast(bf16x8, w);
              w.x = cvt_pk_bf16(p1[8], p1[9]); w.y = cvt_pk_bf16(p1[10], p1[11]); w.z = cvt_pk_bf16(p1[12], p1[13]); w.w = cvt_pk_bf16(p1[14], p1[15]); pf[3] = __builtin_bit_cast(bf16x8, w); }
            const LAS unsigned char* vb = lds + 2 * KBUF + b * VBUF + r32 * VST + hi * 16;
#pragma unroll
            for (int dt = 0; dt < NDT; ++dt)
#pragma unroll
                for (int s = 0; s < 4; ++s) {
                    const bf16x8 vf = *(const LAS bf16x8*)(vb + dt * 32 * VST + s * 32);
                    o[dt] = __builtin_amdgcn_mfma_f32_32x32x16_bf16(vf, pf[s], o[dt], 0, 0, 0);
                    if (DV > 64 && s == 3) __builtin_amdgcn_sched_barrier(0);
                }
        }
        if (t + 1 < NT) ATT_STORE(b ^ 1);
        __syncthreads();
    }
    const float lt = psum(lsum), inv = 1.0f / lt;
    if constexpr (O8) {
        unsigned char* orow8 = (unsigned char*)Op + (size_t)(32 * wid + r32) * op + 4 * hi; const float i8 = inv * Y8_SCALE;
#pragma unroll
        for (int dt = 0; dt < NDT; ++dt)
#pragma unroll
            for (int g = 0; g < 4; ++g) *(unsigned*)(orow8 + 32 * dt + 8 * g) = pk4_fp8(sat8(o[dt][4 * g] * i8), sat8(o[dt][4 * g + 1] * i8), sat8(o[dt][4 * g + 2] * i8), sat8(o[dt][4 * g + 3] * i8));
    } else {
    bf16* orow = Op + (size_t)(32 * wid + r32) * op + 4 * hi;
#pragma unroll
    for (int dt = 0; dt < NDT; ++dt)
#pragma unroll
        for (int g = 0; g < 4; ++g) { v2u w; w.x = cvt_pk_bf16(o[dt][4 * g] * inv, o[dt][4 * g + 1] * inv); w.y = cvt_pk_bf16(o[dt][4 * g + 2] * inv, o[dt][4 * g + 3] * inv);
            *(v2u*)(orow + 32 * dt + 8 * g) = w; }
    }
#undef ATT_LOAD
#undef ATT_STORE
}
__device__ __forceinline__ float max3f(float a, float b, float c) { float r; asm("v_max3_f32 %0, %1, %2, %3" : "=v"(r) : "v"(a), "v"(b), "v"(c)); return r; }
template <int DQK, int DV, bool CAUSAL, int VARIANT = 0>
__device__ __forceinline__ void unit_f(LAS unsigned char* lds, const int wave_in, const bf16* Qp, int qp, const bf16* Kp, int kp, const bf16* Vp, int vp, bf16* Op, int op, int q0, int NT) {
    constexpr int KST = DQK * 2 + 16, VST = 144, KBUF = 64 * KST, VBUF = DV * VST;
    constexpr int NCK = DQK / 8, TOTV = DV * 8, NVI = (TOTV + 511) / 512, ND0 = DQK / 16, NDT = DV / 32;
    static_assert(NCK > 8 && NCK <= 16, "unit_f: K rows of 9..16 chunks");
    const int wid = wave_in, lane = lane_id(), tid = wid * 64 + lane, r32 = lane & 31, hi = lane >> 5;
    const int krow = tid >> 3, kj = tid & 7; const bool kval1 = kj + 8 < NCK;
    const int rho = (krow & ~12) | ((krow & 4) << 1) | ((krow & 8) >> 1);
    const bf16* ksrc0 = Kp + (size_t)krow * kp + 8 * kj; const int kdst0 = rho * KST + 16 * kj;
    const bf16* vsrc[NVI]; int vdst[NVI];
#pragma unroll
    for (int i = 0; i < NVI; ++i) { const int id = tid + 512 * i, d = id >> 3, j = id & 7; vsrc[i] = Vp + (size_t)d * vp + 8 * j; vdst[i] = d * VST + 16 * j; }
    v4u kregA[2], vregA[NVI], kregB[2], vregB[NVI];
#define ATF_LOAD(KR, VR, t) do { KR[0] = *(const v4u*)(ksrc0 + (size_t)(t) * 64 * kp); KR[1] = kval1 ? *(const v4u*)(ksrc0 + (size_t)(t) * 64 * kp + 64) : (v4u){0u, 0u, 0u, 0u}; \
                         _Pragma("unroll") for (int i = 0; i < NVI; ++i) VR[i] = *(const v4u*)(vsrc[i] + (size_t)(t) * 64); } while (0)
#define ATF_STORE(KR, VR, b) do { *(LAS v4u*)(lds + (b) * KBUF + kdst0) = KR[0]; if (kval1) *(LAS v4u*)(lds + (b) * KBUF + kdst0 + 128) = KR[1]; \
                          _Pragma("unroll") for (int i = 0; i < NVI; ++i) *(LAS v4u*)(lds + 2 * KBUF + (b) * VBUF + vdst[i]) = VR[i]; } while (0)
    ATF_LOAD(kregA, vregA, 0);
    if (NT > 1) ATF_LOAD(kregB, vregB, 1);
    bf16x8 qr[ND0];
    { const bf16* qrow = Qp + (size_t)(32 * wid + r32) * qp + hi * 8;
#pragma unroll
      for (int d0 = 0; d0 < ND0; ++d0) qr[d0] = *(const bf16x8*)(qrow + d0 * 16); }
    ATF_STORE(kregA, vregA, 0);
    __syncthreads();
    f32x16 o[NDT];
#pragma unroll
    for (int dt = 0; dt < NDT; ++dt)
#pragma unroll
        for (int r = 0; r < 16; ++r) o[dt][r] = 0.f;
    float mrun = 0.f, lsum = 0.f;
    f32x16 negm;
#pragma unroll
    for (int r = 0; r < 16; ++r) negm[r] = 0.f;
    const int qbase = q0 + 32 * wid, qrow_i = qbase + r32;
#define ATF_ITER(t, LK, LV, SK, SV) do { const int b = (t) & 1; \
        if (VARIANT != 3 && (t) + 2 < NT) ATF_LOAD(LK, LV, (t) + 2); \
        if (!CAUSAL || 64 * t <= qbase + 31) { \
            const LAS unsigned char* kb = lds + b * KBUF + r32 * KST + hi * 16; \
            f32x16 p0 = negm, p1 = negm; \
            _Pragma("unroll") \
            for (int d0 = 0; d0 < ND0; ++d0) { \
                const bf16x8 a0 = *(const LAS bf16x8*)(kb + d0 * 32), a1 = *(const LAS bf16x8*)(kb + 32 * KST + d0 * 32); \
                if (VARIANT != 2) { p0 = __builtin_amdgcn_mfma_f32_32x32x16_bf16(a0, qr[d0], p0, 0, 0, 0); \
                p1 = __builtin_amdgcn_mfma_f32_32x32x16_bf16(a1, qr[d0], p1, 0, 0, 0); } else { p0[d0] += __builtin_bit_cast(float, (int)a0[0]); p1[d0] += __builtin_bit_cast(float, (int)a1[0]); } \
            } \
            asm volatile("s_nop 15\n\ts_nop 7" : "+v"(p0), "+v"(p1)); \
            if (CAUSAL && 64 * t + 63 > qbase) { \
            _Pragma("unroll") \
                for (int r = 0; r < 16; ++r) { const int key = 64 * t + 16 * (r >> 3) + 8 * hi + (r & 7); \
                    if (key > qrow_i) p0[r] = -INFINITY; if (key + 32 > qrow_i) p1[r] = -INFINITY; } \
            } \
            if (VARIANT != 1) { \
            float mt = max3f(p0[0], p1[0], p0[1]), mu = max3f(p1[1], p0[2], p1[2]); \
            _Pragma("unroll") \
            for (int r = 3; r < 15; r += 2) { mt = max3f(mt, p0[r], p1[r]); mu = max3f(mu, p0[r + 1], p1[r + 1]); } \
            mt = pmax(max3f(mt, mu, fmaxf(p0[15], p1[15]))); \
            if (__any(t == 0 || mt > 8.0f)) { \
                const float dl = (t == 0) ? mt : fmaxf(mt, 0.f), sc = __builtin_amdgcn_exp2f(-dl); \
                mrun += dl; lsum *= sc; \
            _Pragma("unroll") \
                for (int r = 0; r < 16; ++r) { p0[r] -= dl; p1[r] -= dl; negm[r] = -mrun; } \
            _Pragma("unroll") \
                for (int dt = 0; dt < NDT; ++dt) \
            _Pragma("unroll") \
                    for (int r = 0; r < 16; ++r) o[dt][r] *= sc; \
            } \
            float ps0 = 0.f, ps1 = 0.f; \
            _Pragma("unroll") \
            for (int r = 0; r < 16; ++r) { p0[r] = __builtin_amdgcn_exp2f(p0[r]); p1[r] = __builtin_amdgcn_exp2f(p1[r]); ps0 += p0[r]; ps1 += p1[r]; } \
            lsum += ps0 + ps1; } \
            bf16x8 pf[4]; \
            { v4u w; \
              w.x = cvt_pk_bf16(p0[0], p0[1]); w.y = cvt_pk_bf16(p0[2], p0[3]); w.z = cvt_pk_bf16(p0[4], p0[5]); w.w = cvt_pk_bf16(p0[6], p0[7]); pf[0] = __builtin_bit_cast(bf16x8, w); \
              w.x = cvt_pk_bf16(p0[8], p0[9]); w.y = cvt_pk_bf16(p0[10], p0[11]); w.z = cvt_pk_bf16(p0[12], p0[13]); w.w = cvt_pk_bf16(p0[14], p0[15]); pf[1] = __builtin_bit_cast(bf16x8, w); \
              w.x = cvt_pk_bf16(p1[0], p1[1]); w.y = cvt_pk_bf16(p1[2], p1[3]); w.z = cvt_pk_bf16(p1[4], p1[5]); w.w = cvt_pk_bf16(p1[6], p1[7]); pf[2] = __builtin_bit_cast(bf16x8, w); \
              w.x = cvt_pk_bf16(p1[8], p1[9]); w.y = cvt_pk_bf16(p1[10], p1[11]); w.z = cvt_pk_bf16(p1[12], p1[13]); w.w = cvt_pk_bf16(p1[14], p1[15]); pf[3] = __builtin_bit_cast(bf16x8, w); } \
            const LAS unsigned char* vb = lds + 2 * KBUF + b * VBUF + r32 * VST + hi * 16; \
            _Pragma("unroll") \
            for (int dt = 0; dt < NDT; ++dt) \
            _Pragma("unroll") \
                for (int s = 0; s < 4; ++s) { \
                    const bf16x8 vf = *(const LAS bf16x8*)(vb + dt * 32 * VST + s * 32); \
                    if (VARIANT != 2) o[dt] = __builtin_amdgcn_mfma_f32_32x32x16_bf16(vf, pf[s], o[dt], 0, 0, 0); else o[dt][s] += __builtin_bit_cast(float, (int)vf[0]) + __builtin_bit_cast(float, (int)pf[s][0]); \
                } \
        } \
        if (VARIANT != 3 && (t) + 1 < NT) ATF_STORE(SK, SV, b ^ 1); \
        __syncthreads(); } while (0)
    for (int t = 0; t < NT; t += 2) {
        ATF_ITER(t, kregA, vregA, kregB, vregB);
        const int t1 = t + 1;
        if (t1 < NT) ATF_ITER(t1, kregB, vregB, kregA, vregA);
    }
#undef ATF_ITER
    const float lt = psum(lsum), inv = 1.0f / lt;
    bf16* orow = Op + (size_t)(32 * wid + r32) * op + 4 * hi;
#pragma unroll
    for (int dt = 0; dt < NDT; ++dt)
#pragma unroll
        for (int g = 0; g < 4; ++g) { v2u w; w.x = cvt_pk_bf16(o[dt][4 * g] * inv, o[dt][4 * g + 1] * inv); w.y = cvt_pk_bf16(o[dt][4 * g + 2] * inv, o[dt][4 * g + 3] * inv);
            *(v2u*)(orow + 32 * dt + 8 * g) = w; }
#undef ATF_LOAD
#undef ATF_STORE
}

template <int DQK, int DV, bool O8 = false>
__device__ __forceinline__ void unit_g(LAS unsigned char* lds, const int wave_in, const bf16* Qp, int qp, const bf16* Kp, int kp, const bf16* Krp, int krp, const bf16* Vp, int vp, bf16* Op, int op, int q0, int NT) {
    constexpr int KST = DQK * 2 + 16, VST = 144, KBUF = 64 * KST, VBUF = DV * VST;
    constexpr int NCK = DQK / 8, TOTV = DV * 8, NVI = (TOTV + 511) / 512, ND0 = DQK / 16, NDT = DV / 32;
    static_assert(NCK > 8 && NCK <= 16, "unit_g: K rows of 9..16 chunks");
    const int wid = wave_in, lane = lane_id(), tid = wid * 64 + lane, r32 = lane & 31, hi = lane >> 5;
    const int krow = tid >> 3, kj = tid & 7; const bool kval1 = kj + 8 < NCK;
    const int rho = (krow & ~12) | ((krow & 4) << 1) | ((krow & 8) >> 1);
    const bf16* ksrc0 = Kp + (size_t)krow * kp + 8 * kj; const bf16* ksrc1 = Krp + (size_t)krow * krp + 8 * kj; const int kdst0 = rho * KST + 16 * kj;
    const bf16* vsrc[NVI]; int vdst[NVI];
#pragma unroll
    for (int i = 0; i < NVI; ++i) { const int id = tid + 512 * i, d = id >> 3, j = id & 7; vsrc[i] = Vp + (size_t)d * vp + 8 * j; vdst[i] = d * VST + 16 * j; }
    v4u kreg[2], vreg[NVI];
#define ATG_LOAD(t) do { kreg[0] = *(const v4u*)(ksrc0 + (size_t)(t) * 64 * kp); kreg[1] = kval1 ? *(const v4u*)(ksrc1 + (size_t)(t) * 64 * krp) : (v4u){0u, 0u, 0u, 0u}; \
                         _Pragma("unroll") for (int i = 0; i < NVI; ++i) vreg[i] = *(const v4u*)(vsrc[i] + (size_t)(t) * 64); } while (0)
#define ATG_STORE(b) do { *(LAS v4u*)(lds + (b) * KBUF + kdst0) = kreg[0]; if (kval1) *(LAS v4u*)(lds + (b) * KBUF + kdst0 + 128) = kreg[1]; \
                          _Pragma("unroll") for (int i = 0; i < NVI; ++i) *(LAS v4u*)(lds + 2 * KBUF + (b) * VBUF + vdst[i]) = vreg[i]; } while (0)
    ATG_LOAD(0);
    bf16x8 qa[ND0], qb[ND0];
    { const bf16* qrow = Qp + (size_t)(64 * wid + r32) * qp + hi * 8;
#pragma unroll
      for (int d0 = 0; d0 < ND0; ++d0) { qa[d0] = *(const bf16x8*)(qrow + d0 * 16); qb[d0] = *(const bf16x8*)(qrow + (size_t)32 * qp + d0 * 16); } }
    ATG_STORE(0);
    __syncthreads();
    f32x16 oa[NDT], ob[NDT];
#pragma unroll
    for (int dt = 0; dt < NDT; ++dt)
#pragma unroll
        for (int r = 0; r < 16; ++r) { oa[dt][r] = 0.f; ob[dt][r] = 0.f; }
    float ma = 0.f, mb = 0.f, la = 0.f, lb = 0.f;
    const int tdiag = (q0 >> 6) + wid, qrel = r32;
#define ATG_SOFTMAX(P0, P1, M, L, O, PF) do { \
        float mt_ = max3f(P0[0], P1[0], P0[1]), mu_ = max3f(P1[1], P0[2], P1[2]); \
        _Pragma("unroll") for (int r = 3; r < 15; r += 2) { mt_ = max3f(mt_, P0[r], P1[r]); mu_ = max3f(mu_, P0[r + 1], P1[r + 1]); } \
        mt_ = pmax(max3f(mt_, mu_, fmaxf(P0[15], P1[15]))); \
        if (__any(t == 0 || mt_ > M + 8.0f)) { const float dl_ = (t == 0) ? mt_ - M : fmaxf(mt_ - M, 0.f), sc_ = __builtin_amdgcn_exp2f(-dl_); M += dl_; L *= sc_; \
            _Pragma("unroll") for (int dt = 0; dt < NDT; ++dt) _Pragma("unroll") for (int r = 0; r < 16; ++r) O[dt][r] *= sc_; } \
        float s0_ = 0.f, s1_ = 0.f; \
        _Pragma("unroll") for (int r = 0; r < 16; ++r) { P0[r] = __builtin_amdgcn_exp2f(P0[r] - M); P1[r] = __builtin_amdgcn_exp2f(P1[r] - M); s0_ += P0[r]; s1_ += P1[r]; } \
        L += s0_ + s1_; \
        { v4u w_; \
          w_.x = cvt_pk_bf16(P0[0], P0[1]); w_.y = cvt_pk_bf16(P0[2], P0[3]); w_.z = cvt_pk_bf16(P0[4], P0[5]); w_.w = cvt_pk_bf16(P0[6], P0[7]); PF[0] = __builtin_bit_cast(bf16x8, w_); \
          w_.x = cvt_pk_bf16(P0[8], P0[9]); w_.y = cvt_pk_bf16(P0[10], P0[11]); w_.z = cvt_pk_bf16(P0[12], P0[13]); w_.w = cvt_pk_bf16(P0[14], P0[15]); PF[1] = __builtin_bit_cast(bf16x8, w_); \
          w_.x = cvt_pk_bf16(P1[0], P1[1]); w_.y = cvt_pk_bf16(P1[2], P1[3]); w_.z = cvt_pk_bf16(P1[4], P1[5]); w_.w = cvt_pk_bf16(P1[6], P1[7]); PF[2] = __builtin_bit_cast(bf16x8, w_); \
          w_.x = cvt_pk_bf16(P1[8], P1[9]); w_.y = cvt_pk_bf16(P1[10], P1[11]); w_.z = cvt_pk_bf16(P1[12], P1[13]); w_.w = cvt_pk_bf16(P1[14], P1[15]); PF[3] = __builtin_bit_cast(bf16x8, w_); } } while (0)
    for (int t = 0; t < NT; ++t) {
        const int b = t & 1;
        if (t + 1 < NT) ATG_LOAD(t + 1);
        if (t <= tdiag) {
            const LAS unsigned char* kb = lds + b * KBUF + r32 * KST + hi * 16;
            f32x16 pa0, pa1, pb0, pb1;
#pragma unroll
            for (int r = 0; r < 16; ++r) { pa0[r] = 0.f; pa1[r] = 0.f; pb0[r] = 0.f; pb1[r] = 0.f; }
#pragma unroll
            for (int d0 = 0; d0 < ND0; ++d0) {
                const bf16x8 a0 = *(const LAS bf16x8*)(kb + d0 * 32), a1 = *(const LAS bf16x8*)(kb + 32 * KST + d0 * 32);
                pa0 = __builtin_amdgcn_mfma_f32_32x32x16_bf16(a0, qa[d0], pa0, 0, 0, 0); pa1 = __builtin_amdgcn_mfma_f32_32x32x16_bf16(a1, qa[d0], pa1, 0, 0, 0);
                pb0 = __builtin_amdgcn_mfma_f32_32x32x16_bf16(a0, qb[d0], pb0, 0, 0, 0); pb1 = __builtin_amdgcn_mfma_f32_32x32x16_bf16(a1, qb[d0], pb1, 0, 0, 0);
            }
            asm volatile("s_nop 15\n\ts_nop 7" : "+v"(pa0), "+v"(pa1), "+v"(pb0), "+v"(pb1));
            if (t == tdiag) {
#pragma unroll
                for (int r = 0; r < 16; ++r) { const int kk = 16 * (r >> 3) + 8 * hi + (r & 7);
                    if (kk > qrel) pa0[r] = -INFINITY; pa1[r] = -INFINITY; if (kk > qrel) pb1[r] = -INFINITY; }
            }
            bf16x8 pfa[4], pfb[4];
            ATG_SOFTMAX(pa0, pa1, ma, la, oa, pfa);
            ATG_SOFTMAX(pb0, pb1, mb, lb, ob, pfb);
            const LAS unsigned char* vb = lds + 2 * KBUF + b * VBUF + r32 * VST + hi * 16;
#pragma unroll
            for (int dt = 0; dt < NDT; ++dt)
#pragma unroll
                for (int s = 0; s < 4; ++s) {
                    const bf16x8 vf = *(const LAS bf16x8*)(vb + dt * 32 * VST + s * 32);
                    oa[dt] = __builtin_amdgcn_mfma_f32_32x32x16_bf16(vf, pfa[s], oa[dt], 0, 0, 0);
                    ob[dt] = __builtin_amdgcn_mfma_f32_32x32x16_bf16(vf, pfb[s], ob[dt], 0, 0, 0);
                }
        }
        if (t + 1 < NT) ATG_STORE(b ^ 1);
        __syncthreads();
    }
    const float ia = 1.0f / psum(la), ib = 1.0f / psum(lb);
    const int lane_e = lane_id();
    if constexpr (O8) {
        unsigned char* orow8 = (unsigned char*)Op + (size_t)(64 * wid + (lane_e & 31)) * op + 4 * (lane_e >> 5); const float ia8 = ia * Y8_SCALE, ib8 = ib * Y8_SCALE;
#pragma unroll
        for (int dt = 0; dt < NDT; ++dt)
#pragma unroll
            for (int g = 0; g < 4; ++g) {
                *(unsigned*)(orow8 + 32 * dt + 8 * g) = pk4_fp8(sat8(oa[dt][4 * g] * ia8), sat8(oa[dt][4 * g + 1] * ia8), sat8(oa[dt][4 * g + 2] * ia8), sat8(oa[dt][4 * g + 3] * ia8));
                *(unsigned*)(orow8 + (size_t)32 * op + 32 * dt + 8 * g) = pk4_fp8(sat8(ob[dt][4 * g] * ib8), sat8(ob[dt][4 * g + 1] * ib8), sat8(ob[dt][4 * g + 2] * ib8), sat8(ob[dt][4 * g + 3] * ib8)); }
    } else {
    bf16* orow = Op + (size_t)(64 * wid + (lane_e & 31)) * op + 4 * (lane_e >> 5);
#pragma unroll
    for (int dt = 0; dt < NDT; ++dt)
#pragma unroll
        for (int g = 0; g < 4; ++g) { v2u w; w.x = cvt_pk_bf16(oa[dt][4 * g] * ia, oa[dt][4 * g + 1] * ia); w.y = cvt_pk_bf16(oa[dt][4 * g + 2] * ia, oa[dt][4 * g + 3] * ia);
            *(v2u*)(orow + 32 * dt + 8 * g) = w;
            w.x = cvt_pk_bf16(ob[dt][4 * g] * ib, ob[dt][4 * g + 1] * ib); w.y = cvt_pk_bf16(ob[dt][4 * g + 2] * ib, ob[dt][4 * g + 3] * ib);
            *(v2u*)(orow + (size_t)32 * op + 32 * dt + 8 * g) = w; }
    }
#undef ATG_LOAD
#undef ATG_STORE
#undef ATG_SOFTMAX
}
}

#define XB_TMO      128
#define XB_XCNT(j)  (256  + 64 * (j))
#define XB_XSUB(j)  (1280 + 64 * (j))
#define XB_XGEN(j)  (2304 + 64 * (j))
#define XB_TOP      3328
#define XB_TOPGEN   3392
#define XCD_BAR_WORDS 3456
#define XB_SPIN_CAP (1u << 18)
__device__ __forceinline__ unsigned xb_ld(unsigned* p)              { return __hip_atomic_load(p, __ATOMIC_RELAXED, __HIP_MEMORY_SCOPE_AGENT); }
__device__ __forceinline__ unsigned xb_add(unsigned* p, unsigned v) { return __hip_atomic_fetch_add(p, v, __ATOMIC_RELAXED, __HIP_MEMORY_SCOPE_AGENT); }
__device__ __forceinline__ unsigned xb_xcc_id() { return (unsigned)__builtin_amdgcn_s_getreg((3 << 11) | 20) & 0xFu; }
#define XB_SPIN(cond, bar) do { unsigned _sp = 0; while (cond) { __builtin_amdgcn_s_sleep(1); \
    if ((++_sp & 255u) == 0u) { if (xb_ld(&(bar)[XB_TMO])) break; if (_sp > XB_SPIN_CAP) { atomicAdd(&(bar)[XB_TMO], 1u); break; } } } } while (0)
struct XcdBarrier { unsigned* bar; unsigned x; volatile LAS unsigned* st; int wave; };
__device__ __forceinline__ XcdBarrier xcd_barrier_post(unsigned* bar, volatile LAS unsigned* st, int wave) {
    XcdBarrier b; b.bar = bar; b.x = xb_xcc_id(); b.st = st; b.wave = wave;
    if (wave == 0 && lane_id() == 0) (void)xb_add(&bar[XB_XCNT(b.x)], 1u);
    return b;
}
__device__ __forceinline__ void xcd_barrier_complete(unsigned* bar, unsigned x, unsigned& nloc, unsigned& nx) {
    const unsigned G = gridDim.x * gridDim.y * gridDim.z;
    unsigned sum, cnt, mine, sp = 0u;
    for (;;) {
        sum = 0u; cnt = 0u; mine = 0u;
#pragma unroll
        for (unsigned j = 0; j < 16; ++j) { const unsigned c = xb_ld(&bar[XB_XCNT(j)]); sum += c; cnt += (c > 0u) ? 1u : 0u; mine = (j == x) ? c : mine; }
        if (sum == G) break;
        __builtin_amdgcn_s_sleep(1);
        if ((++sp & 255u) == 0u) { if (xb_ld(&bar[XB_TMO])) break; if (sp > XB_SPIN_CAP) { atomicAdd(&bar[XB_TMO], 1u); break; } }
    }
    nloc = mine > 0u ? mine : 1u; nx = cnt > 0u ? cnt : 1u;
}
__device__ __forceinline__ void xcd_barrier(const XcdBarrier& b) {
    asm volatile("s_waitcnt vmcnt(0)" ::: "memory");
    __syncthreads();
    if (b.wave == 0 && lane_id() == 0) {
        unsigned* bar = b.bar;
        __builtin_amdgcn_s_waitcnt(0);
        unsigned nloc = b.st[0], nx = b.st[1];
        if (nloc == 0u) { xcd_barrier_complete(bar, b.x, nloc, nx); b.st[0] = nloc; b.st[1] = nx; }
        const unsigned old = xb_add(&bar[XB_XSUB(b.x)], 1u);
        const unsigned gen = old / nloc;
        if (old + 1u == (gen + 1u) * nloc) {
            __builtin_amdgcn_fence(__ATOMIC_RELEASE, "agent");
            asm volatile("s_waitcnt vmcnt(0)" ::: "memory");
            const unsigned og = xb_add(&bar[XB_TOP], 1u);
            const unsigned tg = og / nx;
            if (og + 1u == (tg + 1u) * nx) xb_add(&bar[XB_TOPGEN], 1u);
            else XB_SPIN(xb_ld(&bar[XB_TOPGEN]) == tg, bar);
            __builtin_amdgcn_fence(__ATOMIC_ACQUIRE, "agent");
            xb_add(&bar[XB_XGEN(b.x)], 1u);
            asm volatile("s_waitcnt vmcnt(0)" ::: "memory");
        } else {
            XB_SPIN(xb_ld(&bar[XB_XGEN(b.x)]) == gen, bar);
            __builtin_amdgcn_fence(__ATOMIC_ACQUIRE, "agent");
            asm volatile("s_waitcnt vmcnt(0)" ::: "memory");
        }
    }
    __syncthreads();
}

struct Args { const void* in[29]; float* out; unsigned char* ws; int ph_lo, ph_hi; };
struct Frame {
    LAS unsigned char* lds; int wave, vcu, G;
    __device__ __forceinline__ int lane() const { return lane_id(); }
    __device__ __forceinline__ int tid() const { return wave * 64 + lane_id(); }
};
typedef const __attribute__((address_space(4))) Args* KA;
__device__ __forceinline__ KA kargs() { KA p = (KA)__builtin_amdgcn_kernarg_segment_ptr(); asm volatile("" : "+s"(p)); return p; }

template <class RowFn>
__device__ __forceinline__ void p0_transpose_item(const float* W, int N, const float* gk, int item, LAS float* scr, int lane, RowFn rowfn, unsigned char* w8 = nullptr, int n8lo = 0, float s8 = 1.f, bool all8 = false) {
    const int nblk = N / 32, kb = item / nblk, nb = item % nblk, k0 = 64 * kb, n0 = 32 * nb;
    f32x4 ld[8];
#pragma unroll
    for (int i = 0; i < 8; ++i) ld[i] = *(const f32x4*)(W + (size_t)(k0 + 8 * i + (lane >> 3)) * N + n0 + 4 * (lane & 7));
#pragma unroll
    for (int i = 0; i < 8; ++i) { const int kk = 8 * i + (lane >> 3); f32x4 v = ld[i]; if (gk) v = v * gk[k0 + kk];
        LAS float* d = scr + kk * 33 + 4 * (lane & 7); d[0] = v.x; d[1] = v.y; d[2] = v.z; d[3] = v.w; }
    LDS_WAIT(); asm volatile("" ::: "memory");
    const int c = lane & 7;
#pragma unroll
    for (int j = 0; j < 4; ++j) { const int n = (lane >> 3) + 8 * j; const LAS float* s = scr + (8 * c) * 33 + n;
        if (all8) { v2u o8; o8.x = pk4_fp8(s[0 * 33] * s8, s[1 * 33] * s8, s[2 * 33] * s8, s[3 * 33] * s8); o8.y = pk4_fp8(s[4 * 33] * s8, s[5 * 33] * s8, s[6 * 33] * s8, s[7 * 33] * s8);
            *(v2u*)((unsigned char*)rowfn(n0 + n) + k0 + 8 * c) = o8; continue; }
        if (w8 && n0 + n >= n8lo) { v2u o8; o8.x = pk4_fp8(s[0 * 33] * s8, s[1 * 33] * s8, s[2 * 33] * s8, s[3 * 33] * s8); o8.y = pk4_fp8(s[4 * 33] * s8, s[5 * 33] * s8, s[6 * 33] * s8, s[7 * 33] * s8);
            *(v2u*)((unsigned char*)rowfn(n0 + n) + k0 + 8 * c) = o8; continue; }
        v4u o; o.x = cvt_pk_bf16(s[0 * 33], s[1 * 33]); o.y = cvt_pk_bf16(s[2 * 33], s[3 * 33]); o.z = cvt_pk_bf16(s[4 * 33], s[5 * 33]); o.w = cvt_pk_bf16(s[6 * 33], s[7 * 33]);
        bf16* rp = rowfn(n0 + n); if (rp) *(v4u*)(rp + k0 + 8 * c) = o; }
    LDS_WAIT(); asm volatile("" ::: "memory");
}

template <class RowFn>
__device__ __forceinline__ void p0_transpose_item64(const float* W, int N, const float* gk, int item, LAS float* scr, int lane, RowFn rowfn, float s8, bool all8) {
    const int nblk = N / 64, kb = item / nblk, nb = item % nblk, k0 = 64 * kb, n0 = 64 * nb;
    f32x4 ld[16];
#pragma unroll
    for (int i = 0; i < 16; ++i) ld[i] = *(const f32x4*)(W + (size_t)(k0 + 4 * i + (lane >> 4)) * N + n0 + 4 * (lane & 15));
#pragma unroll
    for (int i = 0; i < 16; ++i) { const int kk = 4 * i + (lane >> 4), nn = 4 * (lane & 15); f32x4 v = ld[i]; if (gk) v = v * gk[k0 + kk];
        LAS float* d = scr + kk * 64; d[(nn + kk) & 63] = v.x; d[(nn + 1 + kk) & 63] = v.y; d[(nn + 2 + kk) & 63] = v.z; d[(nn + 3 + kk) & 63] = v.w; }
    LDS_WAIT(); asm volatile("" ::: "memory");
    const int c = lane & 7;
#pragma unroll
    for (int j = 0; j < 8; ++j) { const int n = (lane >> 3) + 8 * j; float e[8];
#pragma unroll
        for (int i = 0; i < 8; ++i) { const int kk = 8 * c + i; e[i] = scr[kk * 64 + ((n + kk) & 63)]; }
        if (all8) { v2u o8; o8.x = pk4_fp8(e[0] * s8, e[1] * s8, e[2] * s8, e[3] * s8); o8.y = pk4_fp8(e[4] * s8, e[5] * s8, e[6] * s8, e[7] * s8);
            *(v2u*)((unsigned char*)rowfn(n0 + n) + k0 + 8 * c) = o8; }
        else { v4u o; o.x = cvt_pk_bf16(e[0], e[1]); o.y = cvt_pk_bf16(e[2], e[3]); o.z = cvt_pk_bf16(e[4], e[5]); o.w = cvt_pk_bf16(e[6], e[7]); *(v4u*)(rowfn(n0 + n) + k0 + 8 * c) = o; } }
    LDS_WAIT(); asm volatile("" ::: "memory");
}
__device__ __forceinline__ void rms_row_to_bf16(const float* xrow, const float* gain, bf16* orow, int lane, unsigned char* f8row = nullptr) {
    const f32x4* xr = (const f32x4*)xrow + lane; const f32x4* gr = (const f32x4*)gain + lane;
    f32x4 v[4]; float s = 0.f;
#pragma unroll
    for (int j = 0; j < 4; ++j) { v[j] = xr[64 * j]; s += (v[j].x * v[j].x + v[j].y * v[j].y) + (v[j].z * v[j].z + v[j].w * v[j].w); }
    const float rs = rsqrtf(wave_sum(s) * (1.f / 1024.f) + EPS);
    unsigned long long* o8 = (unsigned long long*)orow + lane;
#pragma unroll
    for (int j = 0; j < 4; ++j) { const f32x4 g = gr[64 * j]; const float a = v[j].x * rs * g.x, b = v[j].y * rs * g.y, c = v[j].z * rs * g.z, d = v[j].w * rs * g.w;
        o8[64 * j] = (unsigned long long)cvt_pk_bf16(a, b) | ((unsigned long long)cvt_pk_bf16(c, d) << 32);
        if (f8row) ((unsigned*)f8row)[lane + 64 * j] = pk4_fp8(a, b, c, d); }
}

__device__ __forceinline__ void rms_row2_to_bf16(const float* xa, const float* xb, const float* gain, bf16* oa, bf16* ob, unsigned char* f8a, unsigned char* f8b, int lane) {
    const f32x4* ra = (const f32x4*)xa + lane; const f32x4* rb = (const f32x4*)xb + lane; const f32x4* gr = (const f32x4*)gain + lane;
    f32x4 va[4], vb[4]; float sa = 0.f, sb = 0.f;
#pragma unroll
    for (int j = 0; j < 4; ++j) { va[j] = ra[64 * j]; vb[j] = rb[64 * j]; }
#pragma unroll
    for (int j = 0; j < 4; ++j) { sa += (va[j].x * va[j].x + va[j].y * va[j].y) + (va[j].z * va[j].z + va[j].w * va[j].w); sb += (vb[j].x * vb[j].x + vb[j].y * vb[j].y) + (vb[j].z * vb[j].z + vb[j].w * vb[j].w); }
    const float rsa = rsqrtf(wave_sum(sa) * (1.f / 1024.f) + EPS), rsb = rsqrtf(wave_sum(sb) * (1.f / 1024.f) + EPS);
    unsigned long long* pa = (unsigned long long*)oa + lane; unsigned long long* pb = (unsigned long long*)ob + lane;
#pragma unroll
    for (int j = 0; j < 4; ++j) { const f32x4 g = gr[64 * j]; const f32x4 ya = va[j] * rsa * g, yb = vb[j] * rsb * g;
        pa[64 * j] = (unsigned long long)cvt_pk_bf16(ya.x, ya.y) | ((unsigned long long)cvt_pk_bf16(ya.z, ya.w) << 32);
        pb[64 * j] = (unsigned long long)cvt_pk_bf16(yb.x, yb.y) | ((unsigned long long)cvt_pk_bf16(yb.z, yb.w) << 32);
        ((unsigned*)f8a)[lane + 64 * j] = pk4_fp8(ya.x, ya.y, ya.z, ya.w); ((unsigned*)f8b)[lane + 64 * j] = pk4_fp8(yb.x, yb.y, yb.z, yb.w); }
}

__device__ __forceinline__ void p0_prologue(const Frame& F) {
    const KA ka = kargs(); unsigned char* ws = ka->ws;
    const float* x = (const float*)ka->in[0]; const float* mem = (const float*)ka->in[1]; const int* pos = (const int*)ka->in[2];
    const float* g_mix = (const float*)ka->in[3]; const float* w_in = (const float*)ka->in[4];
    const float* lru_wa = (const float*)ka->in[7]; const float* lru_wx = (const float*)ka->in[9];
    const float* g_q = (const float*)ka->in[12]; const float* w_uq = (const float*)ka->in[13]; const float* g_kv = (const float*)ka->in[14]; const float* w_ukv = (const float*)ka->in[15];
    const float* g_mem = (const float*)ka->in[16]; const float* w_mem_kv = (const float*)ka->in[17]; const float* w_branch = (const float*)ka->in[18]; const float* w_o = (const float*)ka->in[19];
    const float* g_ffn = (const float*)ka->in[20]; const float* w_group = (const float*)ka->in[21]; const float* w_router = (const float*)ka->in[23];
    const float* w_e_gate = (const float*)ka->in[25]; const float* w_e_up = (const float*)ka->in[26]; const float* w_e_down = (const float*)ka->in[27];
    bf16* WIN = (bf16*)(ws + WS_WIN); bf16* WUQ = (bf16*)(ws + WS_WUQ); bf16* WK = (bf16*)(ws + WS_WK); bf16* WV = (bf16*)(ws + WS_WV);
    bf16* WMK = (bf16*)(ws + WS_WMK); bf16* WMV = (bf16*)(ws + WS_WMV); bf16* WBR = (bf16*)(ws + WS_WBR); bf16* WO = (bf16*)(ws + WS_WO);
    bf16* WR = (bf16*)(ws + WS_WR); bf16* WLRU = (bf16*)(ws + WS_WLRU); bf16* W1 = (bf16*)(ws + WS_W1); bf16* W2 = (bf16*)(ws + WS_W2);
    LAS float* scr = (LAS float*)(F.lds + F.wave * 16384);
    const int lane = F.lane();
    const int gw = F.vcu * NWAVES + F.wave, NGW = F.G * NWAVES;
    constexpr int I_IN = 16 * 157, I_UQ = 4 * 24, I_UKV = 2 * 32, I_MKV = 16 * 32, I_BR = 3 * 8 * 32, I_O = 16 * 32, I_EG = 16 * 4, I_ED = 4 * 16, I_EXP = 2 * I_EG + I_ED;
    constexpr int NITEMS = I_IN + I_UQ + I_UKV + I_MKV + I_BR + I_O + NEXP * I_EXP;
    for (int it = gw; it < NITEMS; it += NGW) {
        int r = it;
        if (r < I_IN) { p0_transpose_item(w_in, 5024, nullptr, r, scr, lane, [&](int n) -> bf16* {
                int d; if (n < 1408) d = n; else if (n < 1440) { const int j = n - 1408; d = 1408 + 2 * (j & 15) + (j >> 4); } else d = n + 96;
                return d < 1024 ? WIN + (size_t)d * 1024 : (bf16*)(ws + WS_WG8 + (size_t)(d - 1024) * 1024); }, ws + WS_WG8, 1024, WG8_SCALE); continue; } r -= I_IN;
        if (r < I_UQ) { p0_transpose_item(w_uq, 768, g_q, r, scr, lane, [&](int n) -> bf16* {
                const int h = n / 96, d = n % 96; int dd = d; if (d >= 64) { const int j = d - 64; dd = 64 + 2 * (j & 15) + (j >> 4); }
                return (bf16*)((unsigned char*)WUQ + (size_t)(h * 96 + dd) * 256); }, nullptr, 0, WU8_SCALE, true); continue; } r -= I_UQ;
        if (r < I_UKV) { p0_transpose_item(w_ukv, 1024, g_kv, r, scr, lane, [&](int n) -> bf16* {
                const int h = n >> 7, dd = n & 127; return (bf16*)(dd < 64 ? (unsigned char*)WK + (size_t)(h * 64 + dd) * 256 : (unsigned char*)WV + (size_t)(h * 64 + dd - 64) * 256); }, nullptr, 0, WU8_SCALE, true); continue; } r -= I_UKV;
        if (r < I_MKV) { p0_transpose_item(w_mem_kv, 1024, nullptr, r, scr, lane, [&](int n) -> bf16* {
                return n < 512 ? WMK + (size_t)n * 1024 : WMV + (size_t)(n - 512) * 1024; }); continue; } r -= I_MKV;
        if (r < I_BR) { const int b = r / (8 * 32), rr = r % (8 * 32); p0_transpose_item(w_branch + (size_t)b * 512 * 1024, 1024, nullptr, rr, scr, lane, [&](int n) -> bf16* {
                return WBR + ((size_t)b * 1024 + n) * 512; }, nullptr, 0, b ? WB8_SCALE : 1.f, b != 0); continue; } r -= I_BR;
        if (r < I_O) { p0_transpose_item(w_o, 1024, nullptr, r, scr, lane, [&](int n) -> bf16* { return WO + (size_t)n * 1024; }); continue; } r -= I_O;
        { const int e = r / I_EXP; int q = r % I_EXP;
          unsigned char* const W18 = (unsigned char*)W1;
          if (q < I_EG) { p0_transpose_item64(w_e_gate + (size_t)e * 1024 * 256, 256, g_ffn, q, scr, lane, [&](int n) -> bf16* {
                  return (bf16*)(W18 + ((size_t)e * 512 + (n >> 7) * 256 + (n & 127)) * 1024); }, W18_SCALE, true); continue; } q -= I_EG;
          if (q < I_EG) { p0_transpose_item64(w_e_up + (size_t)e * 1024 * 256, 256, g_ffn, q, scr, lane, [&](int n) -> bf16* {
                  return (bf16*)(W18 + ((size_t)e * 512 + (n >> 7) * 256 + 128 + (n & 127)) * 1024); }, W18_SCALE, true); continue; } q -= I_EG;
          p0_transpose_item64(w_e_down + (size_t)e * 256 * 1024, 1024, nullptr, q, scr, lane, [&](int n) -> bf16* { return (bf16*)((unsigned char*)W2 + ((size_t)e * 1024 + n) * 256); }, W28_SCALE, true); }
    }
    const int gt = F.vcu * (NWAVES * 64) + F.wave * 64 + lane, NGT = F.G * NWAVES * 64;
    for (int i = gt; i < 96 * 1024 / 16; i += NGT) *(v4u*)(ws + WS_WG8 + (size_t)(1440 - 1024) * 1024 + (size_t)i * 16) = (v4u){0u, 0u, 0u, 0u};
    for (int i = gt; i < 2 * 512 * 8; i += NGT) { const int mat = i >> 12, r = (i >> 3) & 511, ch = i & 7; *(v4u*)((unsigned char*)(mat ? WV : WK) + (size_t)r * 256 + 128 + ch * 16) = (v4u){0u, 0u, 0u, 0u}; }
    for (int i = gt; i < 256 * 1024; i += NGT) { const int r = i >> 10, k = i & 1023; float v = 0.f;
        if (r < 32) v = w_router[k * 32 + r] * g_ffn[k]; else if (r >= 128 && r < 132) v = w_group[k * 4 + (r - 128)] * g_ffn[k];
        WR[i] = f2bf(v); }
    for (int i = gt; i < 2 * 8 * 64 * 64; i += NGT) { const int mat = i >> 15, n = (i >> 12) & 7, d = (i >> 6) & 63, c = i & 63;
        const float* src = mat ? lru_wx : lru_wa; WLRU[i] = f2bf(src[(n * 64 + c) * 64 + d]); }
    { float* cosT = (float*)(ws + WS_COS); float* sinT = (float*)(ws + WS_SIN);
      for (int i = gt; i < T * 16; i += NGT) { const int t = i >> 4, f = i & 15;
          const double c4[4] = {1.0, 0.5623413251903491, 0.31622776601683794, 0.1778279410038923};
          double inv = (f & 3) == 0 ? c4[0] : ((f & 3) == 1 ? c4[1] : ((f & 3) == 2 ? c4[2] : c4[3]));
          const int dec = f >> 2; inv *= dec == 0 ? 1.0 : (dec == 1 ? 0.1 : (dec == 2 ? 0.01 : 0.001));
          const double rev = (double)pos[t] * inv * 0.15915494309189535; const float fr = (float)(rev - __builtin_rint(rev));
          cosT[i] = __builtin_amdgcn_cosf(fr); sinT[i] = __builtin_amdgcn_sinf(fr); } }
    bf16* XN = (bf16*)(ws + WS_XN); bf16* MEMN = (bf16*)(ws + WS_MEMN);
    unsigned char* XN8 = (unsigned char*)ka->out + DO_XN8;
    if (T % (2 * NGW) != 0) { for (int m = gw; m < T; m += NGW) rms_row_to_bf16(x + (size_t)m * DM, g_mix, XN + (size_t)m * DM, lane, XN8 + (size_t)m * DM); }
    else for (int m = gw; m < T; m += 2 * NGW) rms_row2_to_bf16(x + (size_t)m * DM, x + (size_t)(m + NGW) * DM, g_mix, XN + (size_t)m * DM, XN + (size_t)(m + NGW) * DM, XN8 + (size_t)m * DM, XN8 + (size_t)(m + NGW) * DM, lane);
    for (int m = gw; m < MROWS; m += NGW) rms_row_to_bf16(mem + (size_t)m * DM, g_mem, MEMN + (size_t)m * DM, lane);
}

template <int PASS>
__device__ __forceinline__ void lru_unit(const Frame& F, int b, int seg) {
    const KA ka = kargs(); unsigned char* ws = ka->ws;
    const float* conv_w = (const float*)ka->in[5]; const float* conv_b = (const float*)ka->in[6]; const float* lru_ba = (const float*)ka->in[8]; const float* lru_bx = (const float*)ka->in[10];
    const float* lam = (const float*)ka->in[11];
    const bf16* XL = (const bf16*)(ws + WS_XL); bf16* GL = (bf16*)(ws + WS_GL); const bf16* WLRU = (const bf16*)(ws + WS_WLRU); float* LSUM = (float*)(ws + WS_LSUM);
    constexpr int XAST = 1040, GST = 2064, XA_OFF = 0, GA_OFF = 16 * XAST, GX_OFF = GA_OFF + 16 * GST;
    const int n = F.wave, lane = lane_id(), c = n * 64 + lane, fr = lane & 15, fq = lane >> 4;
    const float cw0 = conv_w[c], cw1 = conv_w[512 + c], cw2 = conv_w[1024 + c], cw3 = conv_w[1536 + c], cb = conv_b[c], ba = lru_ba[c], bx = lru_bx[c];
    const float sp8 = -8.0f * log1pf(expf(-lam[c]));
    bf16x8 waf[4][2], wxf[4][2];
#pragma unroll
    for (int nt = 0; nt < 4; ++nt)
#pragma unroll
        for (int ks = 0; ks < 2; ++ks) { const size_t o = (size_t)(n * 64 + 16 * nt + fr) * 64 + 32 * ks + 8 * fq;
            waf[nt][ks] = *(const bf16x8*)(WLRU + o); wxf[nt][ks] = *(const bf16x8*)(WLRU + 32768 + o); }
    const size_t t0 = (size_t)b * SEQ + (size_t)seg * 128;
    float xm1 = 0.f, xm2 = 0.f, xm3 = 0.f;
    if (seg > 0) { xm1 = bf2f(XL[(t0 - 1) * 512 + c]); xm2 = bf2f(XL[(t0 - 2) * 512 + c]); xm3 = bf2f(XL[(t0 - 3) * 512 + c]); }
    float h = 0.f, ap = 1.f;
    if (PASS == 2) { const float* sb = LSUM + (size_t)b * 32 * 1024;
        for (int s = 0; s < seg; ++s) h = sb[s * 1024 + c] * h + sb[s * 1024 + 512 + c]; }
    LAS unsigned char* lds = F.lds;
    bf16 xr[16], gr[16];
#pragma unroll
    for (int tt = 0; tt < 16; ++tt) { xr[tt] = XL[(t0 + tt) * 512 + c]; gr[tt] = PASS == 2 ? GL[(t0 + tt) * 512 + c] : (bf16)0; }
    for (int sub = 0; sub < 8; ++sub) {
        const size_t ts = t0 + sub * 16;
        float xav[16], glv[16];
#pragma unroll
        for (int tt = 0; tt < 16; ++tt) { const float x0 = bf2f(xr[tt]);
            if (PASS == 2) glv[tt] = bf2f(gr[tt]);
            const float xa = cw3 * x0 + cw2 * xm1 + cw1 * xm2 + cw0 * xm3 + cb; xm3 = xm2; xm2 = xm1; xm1 = x0; xav[tt] = xa;
            *(LAS bf16*)(lds + XA_OFF + tt * XAST + c * 2) = f2bf(xa); }
        if (sub < 7) {
#pragma unroll
            for (int tt = 0; tt < 16; ++tt) { xr[tt] = XL[(ts + 16 + tt) * 512 + c]; if (PASS == 2) gr[tt] = GL[(ts + 16 + tt) * 512 + c]; }
        }
        { f32x4 aa[4], ax[4];
#pragma unroll
          for (int nt = 0; nt < 4; ++nt) { aa[nt] = (f32x4){0.f, 0.f, 0.f, 0.f}; ax[nt] = (f32x4){0.f, 0.f, 0.f, 0.f}; }
#pragma unroll
          for (int ks = 0; ks < 2; ++ks) { const bf16x8 xf = *(const LAS bf16x8*)(lds + XA_OFF + fr * XAST + (n * 64 + 32 * ks + 8 * fq) * 2);
#pragma unroll
              for (int nt = 0; nt < 4; ++nt) { aa[nt] = __builtin_amdgcn_mfma_f32_16x16x32_bf16(waf[nt][ks], xf, aa[nt], 0, 0, 0); ax[nt] = __builtin_amdgcn_mfma_f32_16x16x32_bf16(wxf[nt][ks], xf, ax[nt], 0, 0, 0); } }
#pragma unroll
          for (int nt = 0; nt < 4; ++nt) { *(LAS f32x4*)(lds + GA_OFF + fr * GST + (n * 64 + 16 * nt + 4 * fq) * 4) = aa[nt]; *(LAS f32x4*)(lds + GX_OFF + fr * GST + (n * 64 + 16 * nt + 4 * fq) * 4) = ax[nt]; } }
#pragma unroll
        for (int tt = 0; tt < 16; ++tt) {
            const float ga = *(const LAS float*)(lds + GA_OFF + tt * GST + c * 4) + ba, gx = *(const LAS float*)(lds + GX_OFF + tt * GST + c * 4) + bx;
            const float r = fast_sigmoid(ga), ig = fast_sigmoid(gx);
            const float la = sp8 * r, av = __builtin_amdgcn_exp2f(la * LOG2E);
            const float mult = __builtin_sqrtf(fmaxf(1.0f - av * av, 0.f));
            h = av * h + mult * ig * xav[tt];
            if (PASS == 1) ap *= av;
            if (PASS == 2) GL[(ts + tt) * 512 + c] = f2bf(h * glv[tt]);
        }
    }
    if (PASS == 1) { float* sb = LSUM + ((size_t)b * 32 + seg) * 1024; sb[c] = ap; sb[512 + c] = h; }
    __syncthreads();
}

__device__ __forceinline__ MoeTab moe_tables(const Frame& F, const unsigned* gcnt) {
    LAS int* p = (LAS int*)(F.lds + MOE_OFF);
    const int tid = F.tid();
    __syncthreads();
    if (tid < 64) {
        const int e = tid & 31, c = (int)gcnt[e], ntl = (c + 255) >> 8;
        int incl = ntl;
#pragma unroll
        for (int o = 1; o < 32; o <<= 1) { const int v = __shfl_up(incl, o, 32); if (e >= o) incl += v; }
        const int excl = incl - ntl;
        if (tid < 32) { p[e] = c; p[32 + e] = excl * 256; p[96 + e] = excl; }
        if (tid == 31) p[64] = incl;
    }
    __syncthreads();
    { const int ntile = p[64];
      if (tid < ntile && tid < MAXTILES) { int e = 0;
#pragma unroll
          for (int k = 1; k < 32; ++k) e += (p[96 + k] <= tid) ? 1 : 0;
          p[128 + tid] = e; p[128 + MAXTILES + tid] = tid - p[96 + e]; } }
    __syncthreads();
    MoeTab t; t.p = p; return t;
}

constexpr int NPHASE = 10;
__global__ void __launch_bounds__(NWAVES * 64, 2) fwd_kernel(Args args) {
    extern __shared__ __attribute__((aligned(16))) unsigned char lds_raw[];
    Frame F;
    F.lds = (LAS unsigned char*)lds_raw;
    F.wave = __builtin_amdgcn_readfirstlane((int)threadIdx.x >> 6);
    F.G = gridDim.x; { const int bx = blockIdx.x; F.vcu = (F.G % 8 == 0) ? (bx % 8) * (F.G / 8) + bx / 8 : bx; }
    const KA ka0 = kargs();
    unsigned* ctl0 = (unsigned*)(ka0->ws + WS_CTL);
    volatile LAS unsigned* MISC = (volatile LAS unsigned*)(F.lds + MISC_OFF);
    { const int t0_ = F.tid(); if (t0_ < 32) MISC[t0_] = 0u; }
    __syncthreads();
    XcdBarrier bar; bar.bar = ctl0 + CW_BAR; bar.x = 0; bar.st = nullptr; bar.wave = F.wave;
    if (!MK_SPLIT) bar = xcd_barrier_post(ctl0 + CW_BAR, MISC + 8, F.wave);
    const int lo = ka0->ph_lo, hi = ka0->ph_hi;
#ifndef PH_MASK
#define PH_MASK 0x3ff
#endif
#define IN(k) (((PH_MASK >> (k)) & 1) && lo <= (k) && (k) < hi)
#define GRID_BAR(k) do { if (!MK_SPLIT && IN((k) + 1)) xcd_barrier(bar); } while (0)

#define PHASE_PTRS const KA ka = kargs(); unsigned char* const ws = ka->ws; unsigned* const ctl = (unsigned*)(ws + WS_CTL); \
    float* const ssq_q = (float*)(ws + WS_SSQQ); float* const ssq_kv = (float*)(ws + WS_SSQKV); float* const ssq_h = (float*)(ws + WS_SSQH); unsigned* const gcnt = ctl + CW_CNT; \
    const float* const cosT = (const float*)(ws + WS_COS); const float* const sinT = (const float*)(ws + WS_SIN); unsigned char* const dob = (unsigned char*)ka->out; \
    bf16* const Qb = (bf16*)(dob + DO_Q); bf16* const Kb = (bf16*)(dob + DO_K); bf16* const Vtb = (bf16*)(dob + DO_VT); \
    (void)ssq_q; (void)ssq_kv; (void)ssq_h; (void)gcnt; (void)cosT; (void)sinT; (void)Qb; (void)Kb; (void)Vtb;

    if (IN(0)) { _Pragma("unroll") for (int rep = 0; rep < REPN(0); ++rep) p0_prologue(F); GRID_BAR(0); }

    if (IN(1)) { PHASE_PTRS
        _Pragma("unroll") for (int rep = 0; rep < REPN(1); ++rep) {
        const bool PSKIP = REPN(1) == 2 && rep == 0 && (PROBE_SKIP == 1 ? (F.vcu & 1) != 0 : PROBE_SKIP == 2 ? (F.vcu >> 5) < 4 : PROBE_SKIP >= 3);
        { const SchedGrid2 S = make_grid1(F.G, F.vcu, T / 256, 4, ws + WS_XN, ws + WS_WIN, 1024, 1024);
          const EpiProj E{(bf16*)(ws + WS_XL), (bf16*)(ws + WS_GL), (bf16*)(ws + WS_CQ), (bf16*)(ws + WS_CKV), (bf16*)(ws + WS_QM), (bf16*)(ws + WS_SG), (bf16*)(dob + DO_KR), ssq_q, ssq_kv, cosT, sinT, PSKIP, 0, 1.0f};
          pg8::gemm_phase<EpiProj, SchedGrid2, true, false>(F.lds, F.wave, 1024, 1024, 1024, S, E); }
        { const SchedGrid2 S = make_grid1(F.G, F.vcu, T / 256, 16, dob + DO_XN8, ws + WS_WG8, 512, 512);
          const EpiProj E{(bf16*)(ws + WS_XL), (bf16*)(ws + WS_GL), (bf16*)(ws + WS_CQ), (bf16*)(ws + WS_CKV), (bf16*)(ws + WS_QM), (bf16*)(ws + WS_SG), (bf16*)(dob + DO_KR), ssq_q, ssq_kv, cosT, sinT, PSKIP, 4, GATE_UNSCALE};
          pg8::gemm_phase<EpiProj, SchedGrid2, true, false, true>(F.lds, F.wave, 512, 512, 512, S, E); }
        }
        GRID_BAR(1);
    }

    if (IN(2)) { PHASE_PTRS
#ifndef SUBM
#define SUBM 0xff
#endif
        _Pragma("unroll") for (int rep = 0; rep < REPN(2); ++rep) {
        const bool deal = (F.G == 256); const int ce = F.vcu < 128 ? F.vcu : F.vcu - 32, Gq = deal ? 224 : F.G;
        const int cq = !deal ? F.vcu : ((F.vcu >= 128 && F.vcu < 160) ? (1 << 20) : ce), ck = !deal ? F.vcu : ((F.vcu >= 128 && F.vcu < 160) ? (1 << 20) : 223 - ce);
        if (SUBM & 1) { const SchedGrid2 S = make_grid1(Gq, cq, T / 256, 3, ws + WS_CQ, ws + WS_WUQ, 128, 128);
          const EpiQ E{Qb, ssq_q, cosT, sinT};
          pg8::gemm_phase<EpiQ, SchedGrid2, true, false, true>(F.lds, F.wave, 128, 128, 128, S, E); }
        if (SUBM & 2) { const SchedGrid2 S = make_grid2(Gq, ck, T / 256, 2, ws + WS_CKV, ws + WS_WK, 2, T / 256, ws + WS_WV, ws + WS_CKV, 128, 128);
          const EpiKV E{Kb, Vtb, ssq_kv};
          pg8::gemm_phase<EpiKV, SchedGrid2, true, false, true>(F.lds, F.wave, 128, 128, 128, S, E); }
        if ((SUBM & 4) && !(PROBE_SKIP == 11 && REPN(2) == 2 && rep == 0)) { const SchedGrid2 S = make_grid2(F.G, (F.vcu + F.G / 2) % F.G, MROWS / 256, 2, ws + WS_MEMN, ws + WS_WMK, 2, MROWS / 256, ws + WS_WMV, ws + WS_MEMN, 1024, 1024);
          const EpiMem E{(bf16*)(ws + WS_MK), (bf16*)(ws + WS_MVT)};
          pg8::gemm_phase<EpiMem, SchedGrid2, true, false>(F.lds, F.wave, 1024, 1024, 1024, S, E); }
        __syncthreads();
        _Pragma("unroll") for (int rep2 = 0; rep2 < REPN(10); ++rep2)
        if (SUBM & 8) for (int u = F.vcu; u < NB * 32; u += F.G) lru_unit<1>(F, u >> 5, u & 31);
        }
        GRID_BAR(2);
    }

    if (IN(3)) { PHASE_PTRS
        bf16* YB = (bf16*)(ws + WS_YB);
        _Pragma("unroll") for (int rep = 0; rep < REPN(3); ++rep)
        if (SUBM & 1) for (int i = 0;; ++i) {
            int bh, qb2;
            if (F.G == 256) { if (i >= 2) break; const int cc = F.vcu & 3; bh = F.vcu >> 2; qb2 = i == 0 ? 7 - cc : cc; }
            else { const int uu = i * F.G + F.vcu; if (uu >= 512) break; bh = uu >> 3; qb2 = 7 - (uu & 7); }
            const int b = bh >> 3, h = bh & 7; const size_t r0 = (size_t)b * SEQ;
            att::unit_g<96, 64, true>(F.lds, F.wave, Qb + (r0 + 512 * qb2) * 768 + h * 96, 768, Kb + r0 * 512 + h * 64, 512, (const bf16*)(dob + DO_KR) + r0 * 32, 32, Vtb + ((size_t)b * 512 + h * 64) * 4096, 4096,
                                (bf16*)((unsigned char*)YB + (r0 + 512 * qb2) * 1024 + h * 64), 1024, 512 * qb2, 8 * (qb2 + 1));
        }
        bf16* QM = (bf16*)(ws + WS_QM); const bf16* MK = (const bf16*)(ws + WS_MK); const bf16* MVT = (const bf16*)(ws + WS_MVT);
        if (SUBM & 2) for (int uu = F.vcu; uu < NB * 4 * 16; uu += F.G) {
            const int b = uu >> 6, h = (uu >> 4) & 3, qb = uu & 15; const size_t r0 = (size_t)b * SEQ + 256 * qb;
            att::unit<128, 128, false, true>(F.lds, F.wave, QM + r0 * 512 + h * 128, 512, MK + (size_t)b * 256 * 512 + h * 128, 512, MVT + ((size_t)b * 512 + h * 128) * 256, 256,
                                       (bf16*)(ws + WS_YC8 + r0 * 1024 + h * 128), 1024, 0, 4);
        }
        if (SUBM & 4) for (int u = F.vcu; u < NB * 32; u += F.G) lru_unit<2>(F, u >> 5, u & 31);
        GRID_BAR(3);
    }

    if (IN(4)) { PHASE_PTRS
        const SchedBranch S{F.G, F.vcu, (const char*)ws};
        EpiBranch E{(const bf16*)(ws + WS_SG), (bf16*)(ws + WS_MG), {}};
#pragma unroll
        for (int k = 0; k < 16; ++k) E.hold[k] = (v2u){0u, 0u};
        _Pragma("unroll") for (int rep = 0; rep < REPN(4); ++rep)
        pg8::gemm_phase<EpiBranch, SchedBranch, true, false, false, true>(F.lds, F.wave, 512, 512, 512, S, E);
        GRID_BAR(4);
    }

    if (IN(5)) { PHASE_PTRS
        const SchedGrid2 S = make_grid1(F.G, F.vcu, T / 256, 4, ws + WS_MG, ws + WS_WO, 1024, 1024);
        _Pragma("unroll") for (int rep = 0; rep < REPN(5); ++rep) {
        const EpiWo E{(const float*)ka->in[0], ka->out, (bf16*)(ws + WS_HB), ssq_h, rep == 0, ws + WS_HB8};
        pg8::gemm_phase<EpiWo, SchedGrid2, true, false>(F.lds, F.wave, 1024, 1024, 1024, S, E); }
        GRID_BAR(5);
    }

    if (IN(6)) { PHASE_PTRS
        const SchedGrid2 S = make_grid1(F.G, F.vcu, T / 256, 1, ws + WS_HB, ws + WS_WR, 1024, 1024);
        const EpiRouter E{ssq_h, (const float*)ka->in[22], (const float*)ka->in[24], gcnt, (int*)(ws + WS_LTOK), (float*)(ws + WS_LW), (int*)(ws + WS_PICK), (float*)(ws + WS_RSH)};
        if (F.G >= T / 256) pg8::gemm_phase<EpiRouter, SchedGrid2, false, false>(F.lds, F.wave, 1024, 1024, 1024, S, E);
        GRID_BAR(6);
    }

    if (IN(7)) { PHASE_PTRS
        const MoeTab tab = moe_tables(F, gcnt);
        const SchedMoe<2, true> S{F.G, F.vcu, tab, (const char*)(ws + WS_HB8), (const char*)(ws + WS_W1), (size_t)512 * 1024, (size_t)256 * 1024, (const int*)(ws + WS_LTOK)};
        const EpiE1 E{(const float*)(ws + WS_RSH), (const int*)(ws + WS_LTOK), (bf16*)(ws + WS_HD), tab};
        _Pragma("unroll") for (int rep = 0; rep < REPN(7); ++rep)
        pg8::gemm_phase<EpiE1, SchedMoe<2, true>, true, true, true>(F.lds, F.wave, 512, 512, 512, S, E);
        GRID_BAR(7);
    }

    if (IN(8)) { PHASE_PTRS
        const MoeTab tab = moe_tables(F, gcnt);
        const SchedMoe<4, false> S{F.G, F.vcu, tab, (const char*)(ws + WS_HD), (const char*)(ws + WS_W2), (size_t)1024 * 256, (size_t)256 * 256, nullptr};
        const EpiE2 E{(const float*)(ws + WS_LW), ws + WS_YE, tab};
        _Pragma("unroll") for (int rep = 0; rep < REPN(8); ++rep)
        pg8::gemm_phase<EpiE2, SchedMoe<4, false>, true, false, true>(F.lds, F.wave, 128, 128, 128, S, E);
        GRID_BAR(8);
    }

    if (IN(9)) { PHASE_PTRS
        const MoeTab tab = moe_tables(F, gcnt);
        const int* pick = (const int*)(ws + WS_PICK); const unsigned char* YE = ws + WS_YE; const float* gfin = (const float*)ka->in[28]; float* outp = ka->out; const bf16* HBp = (const bf16*)(ws + WS_HB);
        const int gw = F.vcu * NWAVES + F.wave, NGW = F.G * NWAVES, lane = F.lane();
        const f32x4* g4 = (const f32x4*)gfin + lane;
#define P9_PICKS(M, MB, P) do { P[0] = pick[2 * (M)]; P[1] = pick[2 * (M) + 1]; P[2] = pick[2 * (MB)]; P[3] = pick[2 * (MB) + 1]; } while (0)
#define P9_LOADS(M, MB, P, WA, WB, EA, EB) do { \
            const unsigned* ya0 = (const unsigned*)(YE + (size_t)(tab.base(P[0] >> 16) + (P[0] & 0xffff)) * DM) + lane; const unsigned* ya1 = (const unsigned*)(YE + (size_t)(tab.base(P[1] >> 16) + (P[1] & 0xffff)) * DM) + lane; \
            const unsigned* yb0 = (const unsigned*)(YE + (size_t)(tab.base(P[2] >> 16) + (P[2] & 0xffff)) * DM) + lane; const unsigned* yb1 = (const unsigned*)(YE + (size_t)(tab.base(P[3] >> 16) + (P[3] & 0xffff)) * DM) + lane; \
            const v2u* ha = (const v2u*)(HBp + (size_t)(M) * DM) + lane; const v2u* hb = (const v2u*)(HBp + (size_t)(MB) * DM) + lane; \
            _Pragma("unroll") for (int j = 0; j < 4; ++j) { WA[j] = ha[64 * j]; EA[j][0] = ya0[64 * j]; EA[j][1] = ya1[64 * j]; WB[j] = hb[64 * j]; EB[j][0] = yb0[64 * j]; EB[j][1] = yb1[64 * j]; } } while (0)
        int pk[4]; v2u wa[4], wb[4]; unsigned ea[4][2], eb[4][2];
        { const int m0 = gw, mb0 = (m0 + NGW < T) ? m0 + NGW : m0; if (m0 < T) { P9_PICKS(m0, mb0, pk); P9_LOADS(m0, mb0, pk, wa, wb, ea, eb); } }
        for (int m = gw; m < T; m += 2 * NGW) {
            const int mb = (m + NGW < T) ? m + NGW : m;
            const int mn = m + 2 * NGW, mbn = (mn + NGW < T) ? mn + NGW : mn; const bool more = mn < T;
            int pn[4] = {0, 0, 0, 0}; if (more) P9_PICKS(mn, mbn, pn);
            f32x4 va[4], vb[4]; float sa = 0.f, sb = 0.f;
#pragma unroll
            for (int j = 0; j < 4; ++j) {
                const f32x2 a0l = __builtin_amdgcn_cvt_pk_f32_fp8((int)ea[j][0], false), a0h = __builtin_amdgcn_cvt_pk_f32_fp8((int)ea[j][0], true), a1l = __builtin_amdgcn_cvt_pk_f32_fp8((int)ea[j][1], false), a1h = __builtin_amdgcn_cvt_pk_f32_fp8((int)ea[j][1], true);
                const f32x2 b0l = __builtin_amdgcn_cvt_pk_f32_fp8((int)eb[j][0], false), b0h = __builtin_amdgcn_cvt_pk_f32_fp8((int)eb[j][0], true), b1l = __builtin_amdgcn_cvt_pk_f32_fp8((int)eb[j][1], false), b1h = __builtin_amdgcn_cvt_pk_f32_fp8((int)eb[j][1], true);
                va[j] = (f32x4){bf_lo(wa[j].x) + a0l[0] + a1l[0], bf_hi(wa[j].x) + a0l[1] + a1l[1], bf_lo(wa[j].y) + a0h[0] + a1h[0], bf_hi(wa[j].y) + a0h[1] + a1h[1]};
                vb[j] = (f32x4){bf_lo(wb[j].x) + b0l[0] + b1l[0], bf_hi(wb[j].x) + b0l[1] + b1l[1], bf_lo(wb[j].y) + b0h[0] + b1h[0], bf_hi(wb[j].y) + b0h[1] + b1h[1]};
                sa += (va[j].x * va[j].x + va[j].y * va[j].y) + (va[j].z * va[j].z + va[j].w * va[j].w); sb += (vb[j].x * vb[j].x + vb[j].y * vb[j].y) + (vb[j].z * vb[j].z + vb[j].w * vb[j].w); }
            if (more) P9_LOADS(mn, mbn, pn, wa, wb, ea, eb);
            const float rsa = rsqrtf(wave_sum(sa) * (1.f / 1024.f) + EPS), rsb = rsqrtf(wave_sum(sb) * (1.f / 1024.f) + EPS);
            f32x4* oa = (f32x4*)(outp + (size_t)m * DM) + lane; f32x4* ob = (f32x4*)(outp + (size_t)mb * DM) + lane;
#pragma unroll
            for (int j = 0; j < 4; ++j) { const f32x4 g = g4[64 * j]; __builtin_nontemporal_store(va[j] * rsa * g, &oa[64 * j]); __builtin_nontemporal_store(vb[j] * rsb * g, &ob[64 * j]); }
        }
#undef P9_PICKS
#undef P9_LOADS
    }
#undef IN
#undef GRID_BAR
}

extern "C" void kernel_launch(void* const* d_in, const int* in_sizes, int n_in, void* d_out, int out_size, void* d_ws, size_t ws_size, hipStream_t stream) {
    static int grid = 0;
    if (grid == 0) {
        if (n_in != 29 || in_sizes[0] != T * DM || out_size != T * DM || ws_size < WS_END) {
            fprintf(stderr, "kernel_launch: unexpected shapes (n_in %d, in0 %d, out %d, ws %zu < %zu); nothing launched\n", n_in, n_in > 0 ? in_sizes[0] : -1, out_size, ws_size, (size_t)WS_END); grid = -1; return; }
        int dev = 0, cus = 0, per_cu = 0;
        if (hipGetDevice(&dev) != hipSuccess || hipDeviceGetAttribute(&cus, hipDeviceAttributeMultiprocessorCount, dev) != hipSuccess) { grid = -1; return; }
        if (hipFuncSetAttribute((const void*)fwd_kernel, hipFuncAttributeMaxDynamicSharedMemorySize, LDS_BYTES) != hipSuccess) { fprintf(stderr, "kernel_launch: hipFuncSetAttribute failed\n"); grid = -1; return; }
        if (hipOccupancyMaxActiveBlocksPerMultiprocessor(&per_cu, (const void*)fwd_kernel, NWAVES * 64, LDS_BYTES) != hipSuccess || per_cu < 1)
            fprintf(stderr, "kernel_launch: note: occupancy query reports %d workgroups per CU\n", per_cu);
        (void)hipGetLastError();
        grid = cus;
    }
    if (grid < 0) return;
    if (hipMemsetAsync((char*)d_ws + WS_CTL, 0, CTL_ZERO_BYTES, stream) != hipSuccess) return;
    Args a{};
    for (int i = 0; i < 29; ++i) a.in[i] = d_in[i];
    a.out = (float*)d_out; a.ws = (unsigned char*)d_ws;
#if MK_SPLIT
    for (int p = 0; p < NPHASE; ++p) { a.ph_lo = p; a.ph_hi = p + 1; hipLaunchKernelGGL(fwd_kernel, dim3(grid), dim3(NWAVES * 64), LDS_BYTES, stream, a); }
#else
    a.ph_lo = 0; a.ph_hi = NPHASE;
    hipLaunchKernelGGL(fwd_kernel, dim3(grid), dim3(NWAVES * 64), LDS_BYTES, stream, a);
#endif
    const hipError_t le = hipPeekAtLastError();
    if (le != hipSuccess) fprintf(stderr, "kernel_launch: launch failed: %s\n", hipGetErrorName(le));
}
```
